# Optimizing an MI355X kernel written in HIP

```python
import jax, jax.numpy as jnp
from jax import lax
import numpy as np

D_MODEL = 2048
BATCH = 16
SEQ = 256
DEPTH = 2
DEC_BATCH = 4
DEC_SEQ = 1024
PAST_LEN = 256

GRID_W = 64
HEAD_DIM = 128
ATT_HEADS = 8
ATT_KV_HEADS = 2
Q_BLOCK = 128
ROPE_THETA = 10000.0
GLA_HEADS = 4
GLA_DK = 128
GLA_DV = 128
GLA_RANK = 16
GLA_TAU = 16.0
GLA_CHUNK = 64
RWKV_HEADS = 8
RWKV_HD = 64
RWKV_W_RANK = 64
RWKV_A_RANK = 64
RWKV_G_RANK = 128
RWKV_DECAY_SCALE = 0.606531
RWKV_LN_EPS = 64e-5
FFN_HIDDEN = 5504
N_BRANCHES = 3
EPS = 1e-6

ATT_Q_W = ATT_HEADS * HEAD_DIM
ATT_KV_W = ATT_KV_HEADS * HEAD_DIM
GLA_W = GLA_HEADS * GLA_DK
GLA_V_W = GLA_HEADS * GLA_DV
RWKV_W = RWKV_HEADS * RWKV_HD
RWKV_COLS = 3 * RWKV_W + 2 * RWKV_W_RANK + RWKV_A_RANK + RWKV_G_RANK
IN_COLS = ATT_Q_W + 2 * ATT_KV_W + 2 * GLA_W + 2 * GLA_V_W + 2 * GLA_RANK + RWKV_COLS + N_BRANCHES * D_MODEL
F32 = jnp.float32

kernel_name = 'hybrid_diffusion_ctx_prefix_step'


def _split(x, sizes):
    idx = [int(i) for i in np.cumsum(sizes)[:-1]]
    return jnp.split(x, idx, axis=-1)


def _rms_norm(x, g, eps=EPS):
    xf = x.astype(F32)
    y = xf * lax.rsqrt(jnp.mean(xf * xf, axis=-1, keepdims=True) + eps)
    return (y * g.astype(F32)).astype(x.dtype)


def _head_layer_norm(x, eps):
    xf = x.astype(F32)
    mu = jnp.mean(xf, axis=-1, keepdims=True)
    xc = xf - mu
    return xc * lax.rsqrt(jnp.mean(xc * xc, axis=-1, keepdims=True) + eps)


def _heads(x, n):
    b, t, _ = x.shape
    return x.reshape(b, t, n, -1).transpose(0, 2, 1, 3)


def _merge(x):
    b, n, t, d = x.shape
    return x.transpose(0, 2, 1, 3).reshape(b, t, n * d)


def _shift_prev(x):
    return jnp.pad(x[:, :-1], ((0, 0), (1, 0), (0, 0)))


def _shift_next(x):
    return jnp.pad(x[:, 1:], ((0, 0), (0, 1), (0, 0)))


def _rope_tables(t):
    rows = t // GRID_W
    row = jnp.repeat(jnp.arange(rows, dtype=F32), GRID_W)
    col = jnp.tile(jnp.arange(GRID_W, dtype=F32), rows)
    half = HEAD_DIM // 2
    inv = ROPE_THETA ** (-jnp.arange(0, half, 2, dtype=F32) / half)

    def cos_sin(pos):
        ang = pos[:, None] * inv[None, :]
        ang = jnp.concatenate([ang, ang], axis=-1)
        return jnp.cos(ang), jnp.sin(ang)

    cos_r, sin_r = cos_sin(row)
    cos_c, sin_c = cos_sin(col)
    return (cos_r, sin_r, cos_c, sin_c)


def _rot_half(x):
    x1, x2 = jnp.split(x, 2, axis=-1)
    return jnp.concatenate([-x2, x1], axis=-1)


def _apply_rope(x, tabs):
    cos_r, sin_r, cos_c, sin_c = tabs
    xr, xc = jnp.split(x.astype(F32), 2, axis=-1)
    xr = xr * cos_r + _rot_half(xr) * sin_r
    xc = xc * cos_c + _rot_half(xc) * sin_c
    return jnp.concatenate([xr, xc], axis=-1).astype(x.dtype)


def _blocked_attention(q, k, v):
    b, hq, t, d = q.shape
    hkv = k.shape[1]
    g = hq // hkv
    nb = t // Q_BLOCK
    qb = q.reshape(b, hkv, g, nb, Q_BLOCK, d).transpose(3, 0, 1, 2, 4, 5)
    scale = d ** -0.5

    def one_block(qblk):
        s = jnp.einsum('bhgqd,bhkd->bhgqk', qblk, k).astype(F32) * scale
        p = jax.nn.softmax(s, axis=-1).astype(v.dtype)
        return jnp.einsum('bhgqk,bhkd->bhgqd', p, v)

    o = lax.map(one_block, qb)
    return o.transpose(1, 2, 3, 0, 4, 5).reshape(b, hq, t, d)


def _gla_chunked(q, k, v, log_a, s0):
    b, h, t, dk = q.shape
    dv = v.shape[-1]
    n = t // GLA_CHUNK
    qc = q.astype(F32).reshape(b, h, n, GLA_CHUNK, dk)
    kc = k.astype(F32).reshape(b, h, n, GLA_CHUNK, dk)
    vc = v.astype(F32).reshape(b, h, n, GLA_CHUNK, dv)
    cum = jnp.cumsum(log_a.astype(F32).reshape(b, h, n, GLA_CHUNK, dk), axis=3)
    cum_last = cum[:, :, :, -1:, :]
    q_e = qc * jnp.exp(cum)
    k_e = kc * jnp.exp(-cum)
    k_l = kc * jnp.exp(cum_last - cum)
    mask = jnp.tril(jnp.ones((GLA_CHUNK, GLA_CHUNK), dtype=bool))
    att = jnp.where(mask, jnp.einsum('bhnid,bhnjd->bhnij', q_e, k_e), 0.0)
    o_intra = jnp.einsum('bhnij,bhnjv->bhniv', att, vc)
    chunk_kv = jnp.einsum('bhnjd,bhnjv->bhndv', k_l, vc)
    decay = jnp.exp(cum_last[:, :, :, 0, :])

    def step(s, inp):
        d, kv_n = inp
        return d[..., None] * s + kv_n, s

    s_fin, s_starts = lax.scan(step, s0.astype(F32), (jnp.moveaxis(decay, 2, 0), jnp.moveaxis(chunk_kv, 2, 0)))
    s_starts = jnp.moveaxis(s_starts, 0, 2)
    o = o_intra + jnp.einsum('bhnid,bhndv->bhniv', q_e, s_starts)
    return o.reshape(b, h, t, dv), s_fin


def _rwkv_scan(r, log_w, k, v, kap, a, s0, reverse):
    xs = tuple(jnp.moveaxis(z, 2, 0) for z in (r, jnp.exp(log_w), k, v, kap, a))

    def step(s, inp):
        r_t, w_t, k_t, v_t, kap_t, a_t = inp
        sk = jnp.einsum('bhvk,bhk->bhv', s, kap_t)
        s = s * w_t[:, :, None, :] - sk[..., None] * (kap_t * a_t)[:, :, None, :] + v_t[..., None] * k_t[:, :, None, :]
        return s, jnp.einsum('bhvk,bhk->bhv', s, r_t)

    s_fin, y = lax.scan(step, s0.astype(F32), xs, reverse=reverse)
    return jnp.moveaxis(y, 0, 2), s_fin


def _mixer(h, p, rope, ctx_kv, gla_s0, rwkv_s0):
    proj = h @ p['w_in']
    aq, ak, av, gq, gk, gv, gg, gad, rw_cols, gates = _split(
        proj, (ATT_Q_W, ATT_KV_W, ATT_KV_W, GLA_W, GLA_W, GLA_V_W, GLA_V_W, 2 * GLA_RANK, RWKV_COLS, N_BRANCHES * D_MODEL))

    q = _rms_norm(_heads(aq, ATT_HEADS), p['q_norm'])
    k = _rms_norm(_heads(ak, ATT_KV_HEADS), p['k_norm'])
    v = _heads(av, ATT_KV_HEADS)
    if rope is not None:
        q = _apply_rope(q, rope)
        k = _apply_rope(k, rope)
    if ctx_kv is None:
        k_all, v_all = k, v
    else:
        k_all = jnp.concatenate([ctx_kv[0].astype(k.dtype), k], axis=2)
        v_all = jnp.concatenate([ctx_kv[1].astype(v.dtype), v], axis=2)
    o_att = _merge(_blocked_attention(q, k_all, v_all))

    gq_h = _heads(gq, GLA_HEADS) * (GLA_DK ** -0.5)
    gk_h = _heads(gk, GLA_HEADS)
    gv_h = _heads(gv, GLA_HEADS)
    gad_f, gad_b = jnp.split(gad, 2, axis=-1)
    la_f = _heads(jax.nn.log_sigmoid((gad_f @ p['gla_a_up'][0] + p['gla_a_bias'][0]).astype(F32)) / GLA_TAU, GLA_HEADS)
    la_b = _heads(jax.nn.log_sigmoid((gad_b @ p['gla_a_up'][1] + p['gla_a_bias'][1]).astype(F32)) / GLA_TAU, GLA_HEADS)
    o_f, s_f = _gla_chunked(gq_h, gk_h, gv_h, la_f, gla_s0[:, 0])
    o_b, s_b = _gla_chunked(jnp.flip(gq_h, 2), jnp.flip(gk_h, 2), jnp.flip(gv_h, 2), jnp.flip(la_b, 2), gla_s0[:, 1])
    o_gla = _merge(_rms_norm(o_f + jnp.flip(o_b, 2), p['gla_norm']))
    o_gla = (o_gla * jax.nn.silu(gg.astype(F32))).astype(h.dtype)

    rw = rw_cols + (0.5 * (_shift_prev(rw_cols) + _shift_next(rw_cols)) - rw_cols) * p['rwkv_mu']
    rr, rk, rv, rwd, rad, rgd = _split(rw, (RWKV_W, RWKV_W, RWKV_W, 2 * RWKV_W_RANK, RWKV_A_RANK, RWKV_G_RANK))
    rwd_f, rwd_b = jnp.split(rwd, 2, axis=-1)
    logw_f = -RWKV_DECAY_SCALE * jax.nn.sigmoid((p['rwkv_w0'][0] + jnp.tanh(rwd_f) @ p['rwkv_w_up'][0]).astype(F32))
    logw_b = -RWKV_DECAY_SCALE * jax.nn.sigmoid((p['rwkv_w0'][1] + jnp.tanh(rwd_b) @ p['rwkv_w_up'][1]).astype(F32))
    a = jax.nn.sigmoid((p['rwkv_a0'] + rad @ p['rwkv_a_up']).astype(F32))
    g_out = jax.nn.sigmoid(rgd) @ p['rwkv_g_up']
    rkf = rk.astype(F32)
    k_rep = rkf * (1.0 + (a - 1.0) * p['rwkv_k_alpha'].astype(F32))
    kap = _heads(rkf * p['rwkv_k_xi'].astype(F32), RWKV_HEADS)
    kap = kap * lax.rsqrt(jnp.sum(kap * kap, axis=-1, keepdims=True) + EPS)
    r_h = _heads(rr.astype(F32), RWKV_HEADS)
    v_h = _heads(rv.astype(F32), RWKV_HEADS)
    k_h = _heads(k_rep, RWKV_HEADS)
    a_h = _heads(a, RWKV_HEADS)
    y_f, st_f = _rwkv_scan(r_h, _heads(logw_f, RWKV_HEADS), k_h, v_h, kap, a_h, rwkv_s0[:, 0], False)
    y_b, st_b = _rwkv_scan(r_h, _heads(logw_b, RWKV_HEADS), k_h, v_h, kap, a_h, rwkv_s0[:, 1], True)
    rho = p['rwkv_bonus'].astype(F32).reshape(RWKV_HEADS, 1, RWKV_HD)
    bonus = jnp.sum(r_h * k_h * rho, axis=-1, keepdims=True) * v_h
    y = _merge(_head_layer_norm(y_f + y_b + bonus, RWKV_LN_EPS)) * p['rwkv_ln_w'].astype(F32) + p['rwkv_ln_b'].astype(F32)
    y = (y * g_out.astype(F32)).astype(h.dtype)

    g_att, g_gla, g_rwkv = jnp.split(jax.nn.sigmoid(gates), N_BRANCHES, axis=-1)
    merged = g_att * (o_att @ p['w_br_att']) + g_gla * (o_gla @ p['w_br_gla']) + g_rwkv * (y @ p['w_br_rwkv'])
    out = merged @ p['w_out']
    return out, k, v, jnp.stack([s_f, s_b], axis=1), jnp.stack([st_f, st_b], axis=1)


def _conv_ffn(h, p):
    u = h @ p['ffn_up']
    w = p['ffn_conv_w']
    u = w[0] * _shift_prev(u) + w[1] * u + w[2] * _shift_next(u) + p['ffn_conv_b']
    val, gate = jnp.split(u, 2, axis=-1)
    return (jax.nn.silu(gate) * val) @ p['ffn_down']


def _layer(x, mod, p, rope, ctx_kv, gla_s0, rwkv_s0):
    sh1, sc1, gt1, sh2, sc2, gt2 = jnp.split(mod, 6, axis=-1)
    h = _rms_norm(x, p['norm_mix']) * (1.0 + sc1) + sh1
    out, k, v, gla_st, rwkv_st = _mixer(h, p, rope, ctx_kv, gla_s0, rwkv_s0)
    x = x + gt1 * out
    h = _rms_norm(x, p['norm_ffn']) * (1.0 + sc2) + sh2
    x = x + gt2 * _conv_ffn(h, p)
    return x, k, v, gla_st, rwkv_st


def setup_inputs(seed: int = 0) -> dict:
    key = jax.random.key(seed)
    ctr = [0]

    def nk():
        ctr[0] += 1
        return jax.random.fold_in(key, ctr[0])

    def nrm(shape, scale=1.0):
        return jax.random.normal(nk(), shape, F32) * scale

    L = DEPTH
    return {
        'x_prompt': nrm((BATCH, SEQ, D_MODEL)),
        'x_sample': nrm((DEC_BATCH, DEC_SEQ, D_MODEL)),
        'cache_k': nrm((DEC_BATCH, L, ATT_KV_HEADS, PAST_LEN, HEAD_DIM)),
        'cache_v': nrm((DEC_BATCH, L, ATT_KV_HEADS, PAST_LEN, HEAD_DIM)),
        'state_gla': nrm((DEC_BATCH, L, 2, GLA_HEADS, GLA_DK, GLA_DV), 0.1),
        'state_rwkv': nrm((DEC_BATCH, L, 2, RWKV_HEADS, RWKV_HD, RWKV_HD), 0.1),
        'c': nrm((DEC_BATCH, D_MODEL)),
        'c_ctx': nrm((D_MODEL,)),
        'w_mod': nrm((L, D_MODEL, 6 * D_MODEL), 0.5 * D_MODEL ** -0.5),
        'b_mod': nrm((L, 6 * D_MODEL), 0.01),
        'norm_mix': 1.0 + nrm((L, D_MODEL), 0.01),
        'w_in': nrm((L, D_MODEL, IN_COLS), D_MODEL ** -0.5),
        'q_norm': 1.0 + nrm((L, HEAD_DIM), 0.01),
        'k_norm': 1.0 + nrm((L, HEAD_DIM), 0.01),
        'gla_a_up': nrm((L, 2, GLA_RANK, GLA_W), GLA_RANK ** -0.5),
        'gla_a_bias': nrm((L, 2, GLA_W), 0.1),
        'gla_norm': 1.0 + nrm((L, GLA_DV), 0.01),
        'rwkv_mu': jax.random.uniform(nk(), (L, RWKV_COLS), F32),
        'rwkv_w0': nrm((L, 2, RWKV_W), 0.5),
        'rwkv_w_up': nrm((L, 2, RWKV_W_RANK, RWKV_W), 0.5 * RWKV_W_RANK ** -0.5),
        'rwkv_a0': nrm((L, RWKV_W), 0.1),
        'rwkv_a_up': nrm((L, RWKV_A_RANK, RWKV_W), RWKV_A_RANK ** -0.5),
        'rwkv_g_up': nrm((L, RWKV_G_RANK, RWKV_W), RWKV_G_RANK ** -0.5),
        'rwkv_k_xi': 0.85 + nrm((L, RWKV_W), 0.05),
        'rwkv_k_alpha': 1.0 + nrm((L, RWKV_W), 0.05),
        'rwkv_bonus': nrm((L, RWKV_W), 0.1),
        'rwkv_ln_w': 1.0 + nrm((L, RWKV_W), 0.01),
        'rwkv_ln_b': nrm((L, RWKV_W), 0.01),
        'w_br_att': nrm((L, ATT_Q_W, D_MODEL), ATT_Q_W ** -0.5),
        'w_br_gla': nrm((L, GLA_V_W, D_MODEL), GLA_V_W ** -0.5),
        'w_br_rwkv': nrm((L, RWKV_W, D_MODEL), RWKV_W ** -0.5),
        'w_out': nrm((L, D_MODEL, D_MODEL), D_MODEL ** -0.5),
        'norm_ffn': 1.0 + nrm((L, D_MODEL), 0.01),
        'ffn_up': nrm((L, D_MODEL, 2 * FFN_HIDDEN), D_MODEL ** -0.5),
        'ffn_conv_w': nrm((L, 3, 2 * FFN_HIDDEN), 3 ** -0.5),
        'ffn_conv_b': nrm((L, 2 * FFN_HIDDEN), 0.01),
        'ffn_down': nrm((L, FFN_HIDDEN, D_MODEL), FFN_HIDDEN ** -0.5),
    }


def reference(x_prompt, x_sample, cache_k, cache_v, state_gla, state_rwkv, c, c_ctx,
              w_mod, b_mod, norm_mix, w_in, q_norm, k_norm, gla_a_up, gla_a_bias, gla_norm,
              rwkv_mu, rwkv_w0, rwkv_w_up, rwkv_a0, rwkv_a_up, rwkv_g_up, rwkv_k_xi, rwkv_k_alpha,
              rwkv_bonus, rwkv_ln_w, rwkv_ln_b, w_br_att, w_br_gla, w_br_rwkv, w_out, norm_ffn,
              ffn_up, ffn_conv_w, ffn_conv_b, ffn_down):
    def layer_params(l):
        return {
            'norm_mix': norm_mix[l], 'w_in': w_in[l], 'q_norm': q_norm[l], 'k_norm': k_norm[l],
            'gla_a_up': gla_a_up[l], 'gla_a_bias': gla_a_bias[l], 'gla_norm': gla_norm[l],
            'rwkv_mu': rwkv_mu[l], 'rwkv_w0': rwkv_w0[l], 'rwkv_w_up': rwkv_w_up[l],
            'rwkv_a0': rwkv_a0[l], 'rwkv_a_up': rwkv_a_up[l], 'rwkv_g_up': rwkv_g_up[l],
            'rwkv_k_xi': rwkv_k_xi[l], 'rwkv_k_alpha': rwkv_k_alpha[l], 'rwkv_bonus': rwkv_bonus[l],
            'rwkv_ln_w': rwkv_ln_w[l], 'rwkv_ln_b': rwkv_ln_b[l], 'w_br_att': w_br_att[l],
            'w_br_gla': w_br_gla[l], 'w_br_rwkv': w_br_rwkv[l], 'w_out': w_out[l],
            'norm_ffn': norm_ffn[l], 'ffn_up': ffn_up[l], 'ffn_conv_w': ffn_conv_w[l],
            'ffn_conv_b': ffn_conv_b[l], 'ffn_down': ffn_down[l],
        }

    b_ctx = x_prompt.shape[0]
    gla_zero = jnp.zeros((b_ctx, 2, GLA_HEADS, GLA_DK, GLA_DV), F32)
    rwkv_zero = jnp.zeros((b_ctx, 2, RWKV_HEADS, RWKV_HD, RWKV_HD), F32)
    x = x_prompt
    ks, vs, gla_states, rwkv_states = [], [], [], []
    for l in range(DEPTH):
        p = layer_params(l)
        mod = (jax.nn.silu(c_ctx) @ w_mod[l] + b_mod[l])[None, None, :]
        x, k_l, v_l, gs, rs = _layer(x, mod, p, None, None, gla_zero, rwkv_zero)
        ks.append(k_l)
        vs.append(v_l)
        gla_states.append(gs)
        rwkv_states.append(rs)
    y_prompt = x
    new_cache_k = jnp.stack(ks, axis=1)
    new_cache_v = jnp.stack(vs, axis=1)
    new_state_gla = jnp.stack(gla_states, axis=1)
    new_state_rwkv = jnp.stack(rwkv_states, axis=1)

    rope = _rope_tables(x_sample.shape[1])
    x = x_sample
    for l in range(DEPTH):
        p = layer_params(l)
        mod = (jax.nn.silu(c) @ w_mod[l] + b_mod[l])[:, None, :]
        x, _, _, _, _ = _layer(x, mod, p, rope, (cache_k[:, l], cache_v[:, l]), state_gla[:, l], state_rwkv[:, l])
    y_sample = x

    return (y_prompt, y_sample, new_cache_k, new_cache_v, new_state_gla, new_state_rwkv)
```

```cpp
#include <hip/hip_runtime.h>
#include <hip/hip_cooperative_groups.h>
#include <cstdio>
namespace cg = cooperative_groups;
__device__ __forceinline__ int tid_l() { int t = (int)threadIdx.x; asm volatile("" : "+v"(t)); return t; }
namespace pg8 {
#define PG8_LAS __attribute__((address_space(3)))
typedef unsigned short bf16_t;
typedef short bf16x8 __attribute__((ext_vector_type(8)));
typedef float f32x4 __attribute__((ext_vector_type(4)));
typedef unsigned u32x4 __attribute__((ext_vector_type(4)));
constexpr int BM = 256, BK = 64, HALF = 128, HTB = HALF * BK * 2  , STAGE_BYTES = 8 * HTB, NXCD = 8, WGM = 8;

__host__ __device__ __forceinline__ int lds_byte(int r, int c) { const int st = (r >> 4) * 2 + (c >> 5), rr = r & 15, cc = c & 31, ob = rr * 64 + cc * 2; return st * 1024 + (ob ^ (((ob >> 9) & 1) << 5)); }
__host__ __device__ __forceinline__ void stage_rc(int b, int& R, int& C) { const int st = b / 1024, sb = b % 1024, swz = sb ^ (((sb >> 9) & 1) << 5); R = (st >> 1) * 16 + swz / 64; C = (st & 1) * 32 + (swz % 64) / 2; }
__host__ __device__ __forceinline__ int perm32(int rho) { const int n = rho >> 4, i = rho & 15; return 8 * (i >> 2) + 4 * n + (i & 3); }

struct Unit { int pm, pn; };
struct Gemm { const bf16_t* A; const bf16_t* Bt; int M, N, K; };

struct StaticOrder {
    int nM, nN, nwg, G, c;
    __host__ __device__ void init(int M, int N, int G_, int c_) { nM = M / BM; nN = N / BM; nwg = nM * nN; G = G_; c = c_; }
    __host__ __device__ bool next(int i, Unit& u) const {
        const long L = (long)i * G + c; if (L >= nwg) return false;
        int wgid = (int)L; { const int q = nwg / NXCD, r = nwg % NXCD, xcd = wgid % NXCD, off = wgid / NXCD; wgid = (xcd < r ? xcd * (q + 1) : r * (q + 1) + (xcd - r) * q) + off; }
        const int nig = WGM * nN, gid = wgid / nig, fm = gid * WGM, gsz = (nM - fm) < WGM ? (nM - fm) : WGM;
        u.pm = fm + ((wgid % nig) % gsz); u.pn = (wgid % nig) / gsz; return true;
    }
    __device__ __forceinline__ void a_ready(const Unit&) const {}
    __device__ __forceinline__ void done(const Unit&) const {}
};
__device__ __forceinline__ unsigned cvt_pk_bf16(float lo, float hi) { unsigned r; asm volatile("v_cvt_pk_bf16_f32 %0, %1, %2" : "=v"(r) : "v"(lo), "v"(hi)); return r; }
typedef float f32x2 __attribute__((ext_vector_type(2)));
template <class Epi, class Sched, bool STAMP = false>
__device__ __forceinline__ void gemm_phase(PG8_LAS unsigned char* lds, const Gemm g, const Sched& S, const Epi& E, unsigned long long* stamps) {
    const int tid = tid_l(), wid = __builtin_amdgcn_readfirstlane(tid >> 6), lane = tid & 63, wr = wid >> 2, wc = wid & 3, fr = lane & 15, fq = lane >> 4;
    const int K = g.K, nt = K / BK;
    int ts_lo = 0, ts_hi = 0, nts = 0; const unsigned long long rt_entry = STAMP ? (unsigned long long)wall_clock64() : 0ull;
#define PG8_STAMP() do { if (STAMP && wid == 0 && nts < 64) { const unsigned long long _c = (unsigned long long)clock64(); \
        ts_lo = (lane == nts) ? (int)(unsigned)_c : ts_lo; ts_hi = (lane == nts) ? (int)(unsigned)(_c >> 32) : ts_hi; ++nts; } } while (0)
    PG8_STAMP();
    unsigned voffA[2], voffB[2];
#pragma unroll
    for (int i = 0; i < 2; ++i) { int R, C; stage_rc(tid * 16 + i * 8192, R, C); const int Rb = Epi::PERM ? ((R & ~31) + perm32(R & 31)) : R;
        voffA[i] = (unsigned)(R * K + C) * 2u; voffB[i] = (unsigned)(Rb * K + C) * 2u; }
    const size_t kstep = (size_t)(BK * 2);
    const size_t hstep = (size_t)HALF * K * 2;
    const size_t tstep = 2 * hstep;
    const unsigned ldsw = (unsigned)wid * 1024u;
    const int aoff = lds_byte(wr * 64 + fr, fq * 8), boff = lds_byte(wc * 32 + fr, fq * 8);
#define PG8_SA(b, h) (((b) * 2 + (h)) * HTB)
#define PG8_SB(b, h) ((4 + (b) * 2 + (h)) * HTB)
#define PG8_STAGE(bufoff, gbase, voff) do { _Pragma("unroll") for (int _i = 0; _i < 2; ++_i) \
        __builtin_amdgcn_global_load_lds((const unsigned*)((const char*)(gbase) + (voff)[_i]), (PG8_LAS unsigned*)(lds + (bufoff) + ldsw + _i * 8192), 16, 0, 0); } while (0)
#define PG8_LDA(dst, b, h) do { _Pragma("unroll") for (int m = 0; m < 4; ++m) _Pragma("unroll") for (int k = 0; k < 2; ++k) dst[m][k] = *(const PG8_LAS bf16x8*)(lds + PG8_SA(b, h) + aoff + m * 2048 + k * 1024); } while (0)
#define PG8_LDB(dst, b, h) do { _Pragma("unroll") for (int n = 0; n < 2; ++n) _Pragma("unroll") for (int k = 0; k < 2; ++k) dst[n][k] = *(const PG8_LAS bf16x8*)(lds + PG8_SB(b, h) + boff + n * 2048 + k * 1024); } while (0)
#define PG8_MMA(ai, bj, At, Bt) do { __builtin_amdgcn_s_setprio(1); _Pragma("unroll") for (int m = 0; m < 4; ++m) _Pragma("unroll") for (int n = 0; n < 2; ++n) _Pragma("unroll") for (int k = 0; k < 2; ++k) \
        acc[ai][bj][m][n] = __builtin_amdgcn_mfma_f32_16x16x32_bf16(Bt[n][k], At[m][k], acc[ai][bj][m][n], 0, 0, 0); __builtin_amdgcn_s_setprio(0); } while (0)
#define PG8_WAIT_V(n) asm volatile("s_waitcnt vmcnt(" #n ")" ::: "memory")
#define PG8_WAIT_L(n) asm volatile("s_waitcnt lgkmcnt(" #n ")" ::: "memory")
#define PG8_BAR __builtin_amdgcn_s_barrier()
#define PG8_SCHED __builtin_amdgcn_sched_barrier(0)
    Unit cur, nxt; int ui = 0;
    if (!S.next(0, cur)) return;
    f32x4 acc[2][2][4][2];
#pragma unroll
    for (int a = 0; a < 2; ++a)
#pragma unroll
        for (int b = 0; b < 2; ++b)
#pragma unroll
            for (int m = 0; m < 4; ++m)
#pragma unroll
                for (int n = 0; n < 2; ++n) acc[a][b][m][n] = (f32x4){0.f, 0.f, 0.f, 0.f};
    bf16x8 At[4][2], B0[2][2], B1[2][2];
    const char* cA = (const char*)g.A + (size_t)cur.pm * tstep; const char* cB = (const char*)g.Bt + (size_t)cur.pn * tstep;
    S.a_ready(cur);
    PG8_STAGE(PG8_SB(0, 0), cB, voffB); PG8_STAGE(PG8_SA(0, 0), cA, voffA); PG8_STAGE(PG8_SB(0, 1), cB + hstep, voffB); PG8_STAGE(PG8_SA(0, 1), cA + hstep, voffA);
    if (wr == 1) PG8_BAR;
    PG8_WAIT_V(4); PG8_BAR;
    PG8_STAGE(PG8_SB(1, 0), cB + kstep, voffB); PG8_STAGE(PG8_SA(1, 0), cA + kstep, voffA); PG8_STAGE(PG8_SB(1, 1), cB + hstep + kstep, voffB);
    PG8_WAIT_V(6); PG8_BAR;
    PG8_STAMP();
    for (;;) {
        const bool has_next = S.next(ui + 1, nxt);
        const char* nA = has_next ? (const char*)g.A + (size_t)nxt.pm * tstep : cA; const char* nB = has_next ? (const char*)g.Bt + (size_t)nxt.pn * tstep : cB;
        for (int t = 0; t < nt; t += 2) {
            const bool last = (t == nt - 2);
            const char* a1 = cA + (size_t)(t + 1) * kstep;
            const char* a2 = last ? nA : cA + (size_t)(t + 2) * kstep; const char* b2 = last ? nB : cB + (size_t)(t + 2) * kstep;
            const char* a3 = a2 + kstep; const char* b3 = b2 + kstep;
            if (last && has_next) S.a_ready(nxt);
            PG8_LDB(B0, 0, 0); PG8_SCHED; PG8_LDA(At, 0, 0); PG8_STAGE(PG8_SA(1, 1), a1 + hstep, voffA);
            PG8_WAIT_L(8); PG8_BAR; PG8_WAIT_L(0); PG8_MMA(0, 0, At, B0); PG8_BAR; PG8_SCHED;
            PG8_LDB(B1, 0, 1); PG8_STAGE(PG8_SB(0, 0), b2, voffB);
            PG8_BAR; PG8_WAIT_L(0); PG8_MMA(0, 1, At, B1); PG8_BAR;
            PG8_LDA(At, 0, 1); PG8_STAGE(PG8_SA(0, 0), a2, voffA);
            PG8_BAR; PG8_WAIT_L(0); PG8_MMA(1, 0, At, B0); PG8_BAR; PG8_SCHED;
            PG8_STAGE(PG8_SB(0, 1), b2 + hstep, voffB);
            PG8_WAIT_V(6); PG8_BAR; PG8_MMA(1, 1, At, B1); PG8_BAR;
            PG8_LDB(B0, 1, 0); PG8_SCHED; PG8_LDA(At, 1, 0); PG8_STAGE(PG8_SA(0, 1), a2 + hstep, voffA);
            PG8_WAIT_L(8); PG8_BAR; PG8_WAIT_L(0); PG8_MMA(0, 0, At, B0); PG8_BAR; PG8_SCHED;
            PG8_LDB(B1, 1, 1); PG8_STAGE(PG8_SB(1, 0), b3, voffB);
            PG8_BAR; PG8_WAIT_L(0); PG8_MMA(0, 1, At, B1); PG8_BAR;
            PG8_LDA(At, 1, 1); PG8_STAGE(PG8_SA(1, 0), a3, voffA);
            PG8_BAR; PG8_WAIT_L(0); PG8_MMA(1, 0, At, B0); PG8_BAR; PG8_SCHED;
            PG8_STAGE(PG8_SB(1, 1), b3 + hstep, voffB);
            PG8_WAIT_V(6); PG8_BAR; PG8_MMA(1, 1, At, B1); PG8_BAR;
        }
        PG8_STAMP();
        if constexpr (!Epi::AFTER_DRAIN) { E(acc, cur, wr, wc, fr, fq); S.done(cur); }
        PG8_STAMP();
        if (!has_next) break;
#pragma unroll
        for (int a = 0; a < 2; ++a)
#pragma unroll
            for (int b = 0; b < 2; ++b)
#pragma unroll
                for (int m = 0; m < 4; ++m)
#pragma unroll
                    for (int n = 0; n < 2; ++n) acc[a][b][m][n] = (f32x4){0.f, 0.f, 0.f, 0.f};
        cur = nxt; cA = nA; cB = nB; ++ui;
    }
    PG8_WAIT_V(0);
    if (wr == 0) PG8_BAR;
    PG8_BAR;
    if constexpr (Epi::AFTER_DRAIN) { E.fused(acc, cur, wr, wc, fr, fq, lds, wid, lane); S.done(cur); }
    PG8_STAMP();
    if (STAMP && wid == 0) { stamps[lane] = lane < nts ? (((unsigned long long)(unsigned)ts_hi << 32) | (unsigned)ts_lo) : 0ull;
        if (lane == 62) stamps[62] = rt_entry; if (lane == 63) stamps[63] = (unsigned long long)wall_clock64(); }
#undef PG8_STAMP
#undef PG8_SA
#undef PG8_SB
#undef PG8_STAGE
#undef PG8_LDA
#undef PG8_LDB
#undef PG8_MMA
#undef PG8_WAIT_V
#undef PG8_WAIT_L
#undef PG8_BAR
#undef PG8_SCHED
}
}

#define LAS __attribute__((address_space(3)))
typedef unsigned short bf16_t;
typedef short bf16x8 __attribute__((ext_vector_type(8)));
typedef short bf16x4 __attribute__((ext_vector_type(4)));
typedef float f32x4 __attribute__((ext_vector_type(4)));
typedef float f32x2 __attribute__((ext_vector_type(2)));
typedef unsigned u32x4 __attribute__((ext_vector_type(4)));
typedef unsigned u32x2 __attribute__((ext_vector_type(2)));
using pg8::cvt_pk_bf16;

constexpr int DM = 2048, NTOK = 8192, NCTX = 4096;
constexpr int PW = 5888;
constexpr int P_AQ = 0, P_AK = 1024, P_AV = 1280, P_GQ = 1536, P_GK = 2048, P_GV = 2560, P_GG = 3072, P_GAD = 3584, P_RW = 3840;
constexpr int GW = 6144;
constexpr int NIN_PAD = 12032;
constexpr int FH = 5504, FU = 11008;
constexpr int SB_STRIDE = 448;
constexpr int LDS_BYTES = 147456;

constexpr size_t O_X = 0, O_CK = 16777216, O_CV = 18874368, O_SG = 20971520, O_SR = 25165824;

constexpr size_t MBy = 1048576;
constexpr size_t WS_W = 0;
constexpr size_t W_IN = 0, W_BRA = 49283072, W_BRG = 53477376, W_BRR = 55574528, W_OUT = 57671680, W_LR = 66060288;
constexpr size_t W_UP = 0, W_DOWN = 45088768;
constexpr size_t WS_A = 68 * MBy;
constexpr size_t WS_P = WS_A, WS_G = WS_A + 192937984, WS_U = WS_A;
constexpr size_t WS_B = WS_A + 280 * MBy;
constexpr size_t WS_SCAN = WS_B, WS_ALR = WS_B + 112 * MBy, WS_GOUT = WS_B + 118 * MBy;
constexpr size_t WS_ABF = WS_B, WS_MBUF = WS_B + 86 * MBy;
constexpr size_t WS_C = WS_B + 150 * MBy;
constexpr size_t WS_KVT = WS_C, WS_SST = WS_C + 64 * MBy, WS_DEC = WS_C + 96 * MBy, WS_YF = WS_C + 97 * MBy, WS_YB = WS_C + 113 * MBy;
constexpr size_t WS_D = WS_C + 129 * MBy;
constexpr size_t WS_H = WS_D, WS_MERGED = WS_D, WS_QB = WS_D + 32 * MBy, WS_KC = WS_D + 48 * MBy, WS_VTC = WS_D + 50 * MBy, WS_KL = WS_D + 52 * MBy, WS_VTL = WS_D + 55 * MBy,
                 WS_OATT = WS_D + 58 * MBy, WS_OGLA = WS_D + 74 * MBy, WS_YRW = WS_D + 82 * MBy, WS_MOD = WS_D + 90 * MBy;
constexpr size_t WS_END = WS_D + 91 * MBy;

struct Params { const float* in[37]; float* out; unsigned char* ws; };
enum { I_XP = 0, I_XS, I_CK, I_CV, I_SG, I_SR, I_C, I_CCTX, I_WMOD, I_BMOD, I_NMIX, I_WIN, I_QN, I_KN, I_GAUP, I_GABIAS, I_GNORM, I_RMU, I_RW0, I_RWUP, I_RA0, I_RAUP, I_RGUP,
       I_RXI, I_RALPHA, I_RBONUS, I_RLNW, I_RLNB, I_WBRA, I_WBRG, I_WBRR, I_WOUT, I_NFFN, I_FUP, I_FCW, I_FCB, I_FDOWN };

__device__ __forceinline__ float wave_sum(float v) {
#pragma unroll
    for (int o = 32; o > 0; o >>= 1) v += __shfl_xor(v, o);
    return v;
}
__device__ __forceinline__ float sigmoidf_(float x) { return 1.0f / (1.0f + __expf(-x)); }
__device__ __forceinline__ float siluf_(float x) { return x / (1.0f + __expf(-x)); }
__device__ __forceinline__ bf16_t f2bf(float f) { unsigned u = __float_as_uint(f); u += 0x7FFFu + ((u >> 16) & 1u); return (bf16_t)(u >> 16); }
__device__ __forceinline__ float bf2f(bf16_t b) { return __uint_as_float(((unsigned)b) << 16); }
__device__ __forceinline__ int mod_index(int tok) { return tok < NCTX ? 0 : 1 + ((tok - NCTX) >> 10); }

__device__ __forceinline__ int win_map(int n) {
    if (n < 3616) return n;
    if (n < 3840) return -1;
    if (n < 5696) return 3616 + (n - 3840);
    if (n < 5888) return -1;
    return 5472 + (n - 5888);
}
__device__ void convert_job(LAS float* tile, const float* __restrict__ src, bf16_t* __restrict__ dst, int K, int Nsrc, int Ndst, int mode, int wg, int nwg) {
    const int tid = tid_l();
    const int tk = K / 64, tn = Ndst / 64, nt = tk * tn;
    for (int t = wg; t < nt; t += nwg) {
        const int k0 = (t % tk) * 64, n0 = (t / tk) * 64;
        {
            const int j = tid & 63, i0 = tid >> 6;
            const int n = n0 + j; const int on = mode ? win_map(n) : n;
#pragma unroll
            for (int r = 0; r < 8; ++r) { const int i = i0 + 8 * r; tile[i * 65 + j] = (on >= 0) ? src[(size_t)(k0 + i) * Nsrc + on] : 0.f; }
        }
        __syncthreads();
        {
            const int k = 2 * (tid & 31);
#pragma unroll
            for (int r = 0; r < 4; ++r) { const int nn = (tid >> 5) + 16 * r;
                const unsigned w = cvt_pk_bf16(tile[k * 65 + nn], tile[(k + 1) * 65 + nn]);
                *(unsigned*)(dst + (size_t)(n0 + nn) * K + k0 + k) = w; }
        }
        __syncthreads();
    }
}
__device__ void convert_lr(const Params& p, int l, bf16_t* dst, int gtid, int gthreads) {
    const float* wup = p.in[I_RWUP] + (size_t)l * 2 * 64 * 512;
    const float* aup = p.in[I_RAUP] + (size_t)l * 64 * 512;
    const float* gup = p.in[I_RGUP] + (size_t)l * 128 * 512;
    for (int idx = gtid; idx < 2048 * 384; idx += gthreads) {
        const int n = idx / 384, k = idx - n * 384; float v = 0.f;
        if (n < 512) { if (k < 64) v = wup[(size_t)k * 512 + n]; }
        else if (n < 1024) { if (k >= 64 && k < 128) v = wup[(size_t)(64 + (k - 64)) * 512 + (n - 512)]; }
        else if (n < 1536) { if (k >= 128 && k < 192) v = aup[(size_t)(k - 128) * 512 + (n - 1024)]; }
        else { if (k >= 192 && k < 320) v = gup[(size_t)(k - 192) * 512 + (n - 1536)]; }
        dst[idx] = f2bf(v);
    }
}

__device__ void mod_phase(const Params& p, LAS float* lds, int wg, int nwg) {
    const int tid = tid_l();
    LAS float* sc = lds;
    LAS float* red = lds + 5 * 2048;
    for (int i = tid; i < 5 * 2048; i += 512) { const int j = i >> 11, k = i & 2047; const float c = (j == 0) ? p.in[I_CCTX][k] : p.in[I_C][(j - 1) * 2048 + k]; sc[i] = siluf_(c); }
    __syncthreads();
    float* mod = (float*)(p.ws + WS_MOD);
    for (int item = wg; item < 256; item += nwg) {
        const int l = item >> 7, col0 = (item & 127) * 96;
        const float* W = p.in[I_WMOD] + (size_t)l * 2048 * 12288;
        const int c4 = tid % 24, kg = tid / 24;
        if (kg < 16) {
            f32x4 acc[5];
#pragma unroll
            for (int j = 0; j < 5; ++j) acc[j] = (f32x4){0.f, 0.f, 0.f, 0.f};
            const float* wp = W + (size_t)(kg * 128) * 12288 + col0 + c4 * 4;
            for (int k = 0; k < 128; ++k) { const f32x4 w = *(const f32x4*)(wp + (size_t)k * 12288);
#pragma unroll
                for (int j = 0; j < 5; ++j) acc[j] += w * sc[j * 2048 + kg * 128 + k]; }
#pragma unroll
            for (int j = 0; j < 5; ++j)
#pragma unroll
                for (int e = 0; e < 4; ++e) red[(kg * 5 + j) * 96 + c4 * 4 + e] = acc[j][e];
        }
        __syncthreads();
        if (tid < 480) { const int j = tid / 96, c = tid % 96; float s = p.in[I_BMOD][l * 12288 + col0 + c];
            for (int g = 0; g < 16; ++g) s += red[(g * 5 + j) * 96 + c];
            mod[((size_t)l * 5 + j) * 12288 + col0 + c] = s; }
        __syncthreads();
    }
}

__device__ void norm_phase(const Params& p, int l, bool first, const float* gamma, int sh_idx, int sc_idx, int gwave, int nwave) {
    const int lane = tid_l() & 63;
    float* x = p.out + O_X; bf16_t* H = (bf16_t*)(p.ws + WS_H);
    const float* mod = (const float*)(p.ws + WS_MOD) + (size_t)l * 5 * 12288;
    for (int tok = gwave; tok < NTOK; tok += nwave) {
        const float* src = first ? (tok < NCTX ? p.in[I_XP] + (size_t)tok * DM : p.in[I_XS] + (size_t)(tok - NCTX) * DM) : x + (size_t)tok * DM;
        const float* mj = mod + (size_t)mod_index(tok) * 12288;
        f32x4 v[8]; float ss = 0.f;
#pragma unroll
        for (int i = 0; i < 8; ++i) { v[i] = *(const f32x4*)(src + lane * 4 + i * 256); ss += v[i][0] * v[i][0] + v[i][1] * v[i][1] + v[i][2] * v[i][2] + v[i][3] * v[i][3]; }
        ss = wave_sum(ss);
        const float rs = rsqrtf(ss * (1.0f / 2048.0f) + 1e-6f);
#pragma unroll
        for (int i = 0; i < 8; ++i) { const int c = lane * 4 + i * 256;
            const f32x4 g = *(const f32x4*)(gamma + c), scv = *(const f32x4*)(mj + sc_idx * 2048 + c), shv = *(const f32x4*)(mj + sh_idx * 2048 + c);
            const f32x4 h = (v[i] * rs * g) * (scv + 1.0f) + shv;
            u32x2 w; w.x = cvt_pk_bf16(h[0], h[1]); w.y = cvt_pk_bf16(h[2], h[3]);
            *(u32x2*)(H + (size_t)tok * DM + c) = w;
            if (first) *(f32x4*)(x + (size_t)tok * DM + c) = v[i]; }
    }
}

template <class F> __device__ __forceinline__ void epi_loop(const f32x4 (&acc)[2][2][4][2], const pg8::Unit& u, int wr, int wc, int fr, int fq, F&& f) {
#pragma unroll
    for (int ai = 0; ai < 2; ++ai)
#pragma unroll
        for (int m = 0; m < 4; ++m) { const int row = u.pm * 256 + ai * 128 + wr * 64 + m * 16 + fr;
#pragma unroll
            for (int bj = 0; bj < 2; ++bj)
#pragma unroll
                for (int n = 0; n < 2; ++n) { const int col = u.pn * 256 + bj * 128 + wc * 32 + n * 16 + 4 * fq; f(row, col, acc[ai][bj][m][n]); } }
}
#define EPI_BEGIN epi_loop(acc, u, wr, wc, fr, fq, [&](const int row, const int col, const f32x4 a) {
#define EPI_END });

struct EpiIn {
    static constexpr bool PERM = false, AFTER_DRAIN = false;
    float* P; bf16_t* G;
    __device__ __forceinline__ void operator()(const f32x4 (&acc)[2][2][4][2], const pg8::Unit& u, int wr, int wc, int fr, int fq) const {
        if (u.pn < 23) { EPI_BEGIN  *(f32x4*)(P + (size_t)row * PW + col) = a;  EPI_END }
        else { EPI_BEGIN  u32x2 w; w.x = cvt_pk_bf16(a[0], a[1]); w.y = cvt_pk_bf16(a[2], a[3]); *(u32x2*)(G + (size_t)row * GW + (col - 5888)) = w;  EPI_END }
    }
};
struct EpiUp {
    static constexpr bool PERM = false, AFTER_DRAIN = false;
    bf16_t* U;
    __device__ __forceinline__ void operator()(const f32x4 (&acc)[2][2][4][2], const pg8::Unit& u, int wr, int wc, int fr, int fq) const {
        EPI_BEGIN  u32x2 w; w.x = cvt_pk_bf16(a[0], a[1]); w.y = cvt_pk_bf16(a[2], a[3]); *(u32x2*)(U + (size_t)row * FU + col) = w;  EPI_END
    }
};
struct EpiRes {
    static constexpr bool PERM = false, AFTER_DRAIN = false;
    float* x; const float* gate;
    __device__ __forceinline__ void operator()(const f32x4 (&acc)[2][2][4][2], const pg8::Unit& u, int wr, int wc, int fr, int fq) const {
        EPI_BEGIN  const f32x4 g = *(const f32x4*)(gate + (size_t)mod_index(row) * 12288 + col); float* xp = x + (size_t)row * DM + col; const f32x4 xv = *(const f32x4*)xp; *(f32x4*)xp = xv + g * a;  EPI_END
    }
};
struct EpiBr {
    static constexpr bool PERM = false, AFTER_DRAIN = false;
    float* Mb; bf16_t* merged; const bf16_t* G; int mode;
    __device__ __forceinline__ void operator()(const f32x4 (&acc)[2][2][4][2], const pg8::Unit& u, int wr, int wc, int fr, int fq) const {
        EPI_BEGIN  const u32x2 gw = *(const u32x2*)(G + (size_t)row * GW + mode * 2048 + col);
            f32x4 g; g[0] = sigmoidf_(__uint_as_float(gw.x << 16)); g[1] = sigmoidf_(__uint_as_float(gw.x & 0xffff0000u)); g[2] = sigmoidf_(__uint_as_float(gw.y << 16)); g[3] = sigmoidf_(__uint_as_float(gw.y & 0xffff0000u));
            float* mp = Mb + (size_t)row * DM + col; f32x4 r = g * a;
            if (mode > 0) r += *(const f32x4*)mp;
            if (mode < 2) *(f32x4*)mp = r;
            else { u32x2 w; w.x = cvt_pk_bf16(r[0], r[1]); w.y = cvt_pk_bf16(r[2], r[3]); *(u32x2*)(merged + (size_t)row * DM + col) = w; }  EPI_END
    }
};
struct EpiLr {
    static constexpr bool PERM = false, AFTER_DRAIN = false;
    float* scan; float* gout; const float* w0; const float* a0; const float* alpha;
    __device__ __forceinline__ void operator()(const f32x4 (&acc)[2][2][4][2], const pg8::Unit& u, int wr, int wc, int fr, int fq) const {
        const int sect = u.pn >> 1;
        EPI_BEGIN  const int c = col & 511; float* sb = scan + ((size_t)row * 8 + (c >> 6)) * SB_STRIDE + (c & 63);
            if (sect < 2) { const f32x4 b = *(const f32x4*)(w0 + sect * 512 + c); f32x4 w;
#pragma unroll
                for (int e = 0; e < 4; ++e) w[e] = __expf(-0.606531f * sigmoidf_(b[e] + a[e]));
                *(f32x4*)(sb + 320 + sect * 64) = w; }
            else if (sect == 2) { const f32x4 b = *(const f32x4*)(a0 + c), al = *(const f32x4*)(alpha + c); const f32x4 rk = *(const f32x4*)(sb + 64), kap = *(const f32x4*)(sb + 192); f32x4 kk, ka;
#pragma unroll
                for (int e = 0; e < 4; ++e) { const float av = sigmoidf_(b[e] + a[e]); kk[e] = rk[e] * (1.0f + (av - 1.0f) * al[e]); ka[e] = kap[e] * av; }
                *(f32x4*)(sb + 64) = kk; *(f32x4*)(sb + 256) = ka; }
            else { *(f32x4*)(gout + (size_t)row * 512 + c) = a; }  EPI_END
    }
};

template <class Epi> __device__ __forceinline__ void run_gemm(LAS unsigned char* lds, const bf16_t* A, const bf16_t* Bt, int N, int K, const Epi& E) {
    asm volatile("" : "+s"(N)); asm volatile("" : "+s"(K));
    pg8::Gemm g; g.A = A; g.Bt = Bt; g.M = NTOK; g.N = N; g.K = K;
    pg8::StaticOrder S; S.init(NTOK, N, (int)gridDim.x, (int)blockIdx.x);
    pg8::gemm_phase<Epi, pg8::StaticOrder, false>(lds, g, S, E, nullptr);
    __syncthreads();
}

__device__ void prep_phase(const Params& p, int l, int gwave, int nwave) {
    const int lane = tid_l() & 63;
    const float* P = (const float*)(p.ws + WS_P);
    bf16_t* Qb = (bf16_t*)(p.ws + WS_QB); bf16_t* Kc = (bf16_t*)(p.ws + WS_KC); bf16_t* Vtc = (bf16_t*)(p.ws + WS_VTC); bf16_t* Kl = (bf16_t*)(p.ws + WS_KL); bf16_t* Vtl = (bf16_t*)(p.ws + WS_VTL);
    float* scan = (float*)(p.ws + WS_SCAN); bf16_t* Alr = (bf16_t*)(p.ws + WS_ALR);
    for (int it = gwave; it < 2048; it += nwave) {
        const int t = it & 255, h = (it >> 8) & 1, b = it >> 9;
        const size_t src = ((((size_t)b * 2 + l) * 2 + h) * 256 + t) * 128;
        const f32x2 kv = *(const f32x2*)(p.in[I_CK] + src + lane * 2), vv = *(const f32x2*)(p.in[I_CV] + src + lane * 2);
        *(unsigned*)(Kl + (((size_t)b * 2 + h) * 1280 + t) * 128 + lane * 2) = cvt_pk_bf16(kv[0], kv[1]);
        Vtl[(((size_t)b * 2 + h) * 128 + lane * 2) * 1280 + t] = f2bf(vv[0]);
        Vtl[(((size_t)b * 2 + h) * 128 + lane * 2 + 1) * 1280 + t] = f2bf(vv[1]);
    }
    const float* qn = p.in[I_QN] + l * 128; const float* kn = p.in[I_KN] + l * 128;
    const float* mu = p.in[I_RMU] + l * 1856; const float* xi = p.in[I_RXI] + l * 512;
    const int hf = lane >> 5, ii = lane & 31, d0 = hf * 64 + ii, d1 = d0 + 32;
    const float inv = exp2f(-(float)(2 * ii) * (13.287712379549449f / 64.0f));
    for (int tok = gwave; tok < NTOK; tok += nwave) {
        const bool lat = tok >= NCTX;
        const int b = lat ? (tok - NCTX) >> 10 : tok >> 8, t = lat ? (tok - NCTX) & 1023 : tok & 255, T = lat ? 1024 : 256;
        const float* pr = P + (size_t)tok * PW;
        float cs = 1.f, sn = 0.f;
        if (lat) { const float pos = (float)(hf == 0 ? (t >> 6) : (t & 63)); sincosf(pos * inv, &sn, &cs); }
#pragma unroll 1
        for (int slot = 0; slot < 12; ++slot) {
            const int col = slot < 8 ? P_AQ + slot * 128 : (slot < 10 ? P_AK + (slot - 8) * 128 : P_AV + (slot - 10) * 128);
            float x0 = pr[col + d0], x1 = pr[col + d1];
            if (slot < 10) {
                const float ss = wave_sum(x0 * x0 + x1 * x1); const float rs = rsqrtf(ss * (1.0f / 128.0f) + 1e-6f);
                const float* g = slot < 8 ? qn : kn; x0 = x0 * rs * g[d0]; x1 = x1 * rs * g[d1];
                if (lat) { const float r0 = x0 * cs - x1 * sn, r1 = x1 * cs + x0 * sn; x0 = r0; x1 = r1; }
            }
            if (slot < 8) { bf16_t* q = Qb + (size_t)tok * 1024 + slot * 128; q[d0] = f2bf(x0); q[d1] = f2bf(x1); }
            else if (slot < 10) { const int h = slot - 8;
                if (!lat) { float* o = p.out + O_CK + ((((size_t)b * 2 + l) * 2 + h) * 256 + t) * 128; o[d0] = x0; o[d1] = x1;
                            bf16_t* kc = Kc + (((size_t)b * 2 + h) * 256 + t) * 128; kc[d0] = f2bf(x0); kc[d1] = f2bf(x1); }
                else { bf16_t* kl = Kl + (((size_t)b * 2 + h) * 1280 + 256 + t) * 128; kl[d0] = f2bf(x0); kl[d1] = f2bf(x1); } }
            else { const int h = slot - 10;
                if (!lat) { float* o = p.out + O_CV + ((((size_t)b * 2 + l) * 2 + h) * 256 + t) * 128; o[d0] = x0; o[d1] = x1;
                            bf16_t* vt = Vtc + ((size_t)b * 2 + h) * 128 * 256 + t; vt[(size_t)d0 * 256] = f2bf(x0); vt[(size_t)d1 * 256] = f2bf(x1); }
                else { bf16_t* vt = Vtl + ((size_t)b * 2 + h) * 128 * 1280 + 256 + t; vt[(size_t)d0 * 1280] = f2bf(x0); vt[(size_t)d1 * 1280] = f2bf(x1); } }
        }
        const bool hp = t > 0, hn = t < T - 1;
#pragma unroll 1
        for (int itc = 0; itc < 29; ++itc) {
            const int c = itc * 64 + lane;
            const float xc = pr[P_RW + c], xp = hp ? pr[P_RW + c - PW] : 0.f, xn = hn ? pr[P_RW + c + PW] : 0.f;
            const float mx = xc + (0.5f * (xp + xn) - xc) * mu[c];
            if (itc < 8) { scan[((size_t)tok * 8 + itc) * SB_STRIDE + lane] = mx; }
            else if (itc < 16) { const int h = itc - 8; float* sb = scan + ((size_t)tok * 8 + h) * SB_STRIDE;
                sb[64 + lane] = mx;
                const float kx = mx * xi[h * 64 + lane]; const float ss = wave_sum(kx * kx); sb[192 + lane] = kx * rsqrtf(ss + 1e-6f); }
            else if (itc < 24) { scan[((size_t)tok * 8 + (itc - 16)) * SB_STRIDE + 128 + lane] = mx; }
            else { const int cc = c - 1536;
                const float v = cc < 128 ? tanhf(mx) : (cc < 192 ? mx : sigmoidf_(mx));
                Alr[(size_t)tok * 384 + cc] = f2bf(v); }
        }
        Alr[(size_t)tok * 384 + 320 + lane] = 0;
    }
}

template <int QT> __device__ void attn_item(const bf16_t* __restrict__ Q, const bf16_t* __restrict__ K, const bf16_t* __restrict__ Vt, int Tk, bf16_t* __restrict__ O, int lane) {
    const int fr = lane & 15, fq = lane >> 4;
    bf16x8 qf[QT][4];
#pragma unroll
    for (int t = 0; t < QT; ++t)
#pragma unroll
        for (int kc = 0; kc < 4; ++kc) qf[t][kc] = *(const bf16x8*)(Q + (size_t)(t * 16 + fr) * 1024 + kc * 32 + fq * 8);
    f32x4 o[QT][8]; float mrun[QT], lrun[QT];
#pragma unroll
    for (int t = 0; t < QT; ++t) { mrun[t] = -1e30f; lrun[t] = 0.f;
#pragma unroll
        for (int dt = 0; dt < 8; ++dt) o[t][dt] = (f32x4){0.f, 0.f, 0.f, 0.f}; }
    const float scl = 0.08838834764831845f * 1.4426950408889634f;
    for (int kb = 0; kb < Tk; kb += 32) {
        bf16x8 kf[2][4];
#pragma unroll
        for (int kt = 0; kt < 2; ++kt)
#pragma unroll
            for (int kc = 0; kc < 4; ++kc) kf[kt][kc] = *(const bf16x8*)(K + (size_t)(kb + kt * 16 + fr) * 128 + kc * 32 + fq * 8);
        bf16x8 pb[QT];
#pragma unroll
        for (int t = 0; t < QT; ++t) {
            f32x4 s0 = (f32x4){0.f, 0.f, 0.f, 0.f}, s1 = (f32x4){0.f, 0.f, 0.f, 0.f};
#pragma unroll
            for (int kc = 0; kc < 4; ++kc) { s0 = __builtin_amdgcn_mfma_f32_16x16x32_bf16(kf[0][kc], qf[t][kc], s0, 0, 0, 0); s1 = __builtin_amdgcn_mfma_f32_16x16x32_bf16(kf[1][kc], qf[t][kc], s1, 0, 0, 0); }
            s0 *= scl; s1 *= scl;
            float mx = fmaxf(fmaxf(fmaxf(s0[0], s0[1]), fmaxf(s0[2], s0[3])), fmaxf(fmaxf(s1[0], s1[1]), fmaxf(s1[2], s1[3])));
            mx = fmaxf(mx, __shfl_xor(mx, 16)); mx = fmaxf(mx, __shfl_xor(mx, 32));
            const float mnew = fmaxf(mrun[t], mx), alpha = exp2f(mrun[t] - mnew); mrun[t] = mnew;
            float ps = 0.f;
#pragma unroll
            for (int e = 0; e < 4; ++e) { s0[e] = exp2f(s0[e] - mnew); s1[e] = exp2f(s1[e] - mnew); ps += s0[e] + s1[e]; }
            lrun[t] = lrun[t] * alpha + ps;
#pragma unroll
            for (int dt = 0; dt < 8; ++dt) o[t][dt] *= alpha;
            u32x4 w; w.x = cvt_pk_bf16(s0[0], s0[1]); w.y = cvt_pk_bf16(s0[2], s0[3]); w.z = cvt_pk_bf16(s1[0], s1[1]); w.w = cvt_pk_bf16(s1[2], s1[3]);
            pb[t] = __builtin_bit_cast(bf16x8, w);
        }
#pragma unroll
        for (int dt = 0; dt < 8; ++dt) {
            const bf16_t* vp = Vt + (size_t)(dt * 16 + fr) * Tk + kb + fq * 4;
            const u32x2 va = *(const u32x2*)vp, vb = *(const u32x2*)(vp + 16);
            u32x4 vw; vw.x = va.x; vw.y = va.y; vw.z = vb.x; vw.w = vb.y;
            const bf16x8 vf = __builtin_bit_cast(bf16x8, vw);
#pragma unroll
            for (int t = 0; t < QT; ++t) o[t][dt] = __builtin_amdgcn_mfma_f32_16x16x32_bf16(vf, pb[t], o[t][dt], 0, 0, 0);
        }
    }
#pragma unroll
    for (int t = 0; t < QT; ++t) {
        float l = lrun[t]; l += __shfl_xor(l, 16); l += __shfl_xor(l, 32);
        const float li = 1.0f / l;
#pragma unroll
        for (int dt = 0; dt < 8; ++dt) { const f32x4 v = o[t][dt] * li; u32x2 w; w.x = cvt_pk_bf16(v[0], v[1]); w.y = cvt_pk_bf16(v[2], v[3]);
            *(u32x2*)(O + (size_t)(t * 16 + fr) * 1024 + dt * 16 + fq * 4) = w; }
    }
}
__device__ void attn_phase(const Params& p) {
    const int wid = tid_l() >> 6, lane = tid_l() & 63;
    const bf16_t* Qb = (const bf16_t*)(p.ws + WS_QB); bf16_t* Oa = (bf16_t*)(p.ws + WS_OATT);
    const bf16_t* Kc = (const bf16_t*)(p.ws + WS_KC); const bf16_t* Vtc = (const bf16_t*)(p.ws + WS_VTC); const bf16_t* Kl = (const bf16_t*)(p.ws + WS_KL); const bf16_t* Vtl = (const bf16_t*)(p.ws + WS_VTL);
    for (int i = blockIdx.x * 4 + (wid & 3); i < 1024; i += gridDim.x * 4) {
        if (wid < 4) {
            const int qt = i & 31, hq = (i >> 5) & 7, b = i >> 8, hk = hq >> 2;
            const size_t tok0 = NCTX + (size_t)b * 1024 + qt * 32;
            attn_item<2>(Qb + tok0 * 1024 + hq * 128, Kl + ((size_t)b * 2 + hk) * 1280 * 128, Vtl + ((size_t)b * 2 + hk) * 128 * 1280, 1280, Oa + tok0 * 1024 + hq * 128, lane);
        } else {
            const int qt = i & 7, hq = (i >> 3) & 7, b = i >> 6, hk = hq >> 2;
            const size_t tok0 = (size_t)b * 256 + qt * 32;
            attn_item<2>(Qb + tok0 * 1024 + hq * 128, Kc + ((size_t)b * 2 + hk) * 256 * 128, Vtc + ((size_t)b * 2 + hk) * 128 * 256, 256, Oa + tok0 * 1024 + hq * 128, lane);
        }
    }
}

constexpr int GL_GAD = 0, GL_TOT = 4096, GL_QE = 6144, GL_KE = 23552, GL_KLT = 40960, GL_VT = 59392, GL_OSUM = 77824;
__device__ __forceinline__ float log_sigmoidf_(float z) { return fminf(z, 0.f) - log1pf(__expf(-fabsf(z))); }
__device__ float gla_stage(LAS unsigned char* lds, const Params& p, int l, int h, int cg, int dir) {
    const int tid = tid_l(), d = tid & 127, qtr = tid >> 7;
    const float* P = (const float*)(p.ws + WS_P);
    LAS float* gadL = (LAS float*)(lds + GL_GAD); LAS float* tot = (LAS float*)(lds + GL_TOT);
    LAS bf16_t* qe = (LAS bf16_t*)(lds + GL_QE); LAS bf16_t* ke = (LAS bf16_t*)(lds + GL_KE); LAS bf16_t* klT = (LAS bf16_t*)(lds + GL_KLT); LAS bf16_t* vT = (LAS bf16_t*)(lds + GL_VT);
    const int tbase = cg * 64;
    { const int idx = tid * 2, i = idx >> 4, r = idx & 15; const int tok = dir ? tbase + 63 - i : tbase + i;
      const f32x2 g = *(const f32x2*)(P + (size_t)tok * PW + P_GAD + dir * 16 + r); gadL[idx] = g[0]; gadL[idx + 1] = g[1]; }
    const float* aup = p.in[I_GAUP] + ((size_t)l * 2 + dir) * 16 * 512 + h * 128 + d;
    float au[16];
#pragma unroll
    for (int r = 0; r < 16; ++r) au[r] = aup[r * 512];
    const float bias = p.in[I_GABIAS][((size_t)l * 2 + dir) * 512 + h * 128 + d];
    __syncthreads();
    float cl[16]; float c = 0.f;
#pragma unroll
    for (int k = 0; k < 16; ++k) { const int i = qtr * 16 + k; float z = bias;
#pragma unroll
        for (int r = 0; r < 16; ++r) z += gadL[i * 16 + r] * au[r];
        c += log_sigmoidf_(z) * (1.0f / 16.0f); cl[k] = c; }
    tot[qtr * 128 + d] = c;
    __syncthreads();
    float off = 0.f, clast = 0.f;
#pragma unroll
    for (int q = 0; q < 4; ++q) { const float tv = tot[q * 128 + d]; clast += tv; if (q < qtr) off += tv; }
#pragma unroll
    for (int k = 0; k < 16; ++k) { const int i = qtr * 16 + k; const int tok = dir ? tbase + 63 - i : tbase + i; const float* pr = P + (size_t)tok * PW + h * 128 + d;
        const float cm = cl[k] + off; const float q = pr[P_GQ], kv = pr[P_GK], v = pr[P_GV];
        qe[i * 136 + d] = f2bf(q * 0.08838834764831845f * __expf(cm)); ke[i * 136 + d] = f2bf(kv * __expf(-cm));
        klT[d * 72 + i] = f2bf(kv * __expf(clast - cm)); vT[d * 72 + i] = f2bf(v); }
    __syncthreads();
    return __expf(clast);
}
__device__ void gla_g1(LAS unsigned char* lds, const Params& p, int l) {
    const int tid = tid_l(), wid = tid >> 6, lane = tid & 63, fr = lane & 15, fq = lane >> 4;
    float* KVt = (float*)(p.ws + WS_KVT); float* DEC = (float*)(p.ws + WS_DEC);
    LAS bf16_t* klT = (LAS bf16_t*)(lds + GL_KLT); LAS bf16_t* vT = (LAS bf16_t*)(lds + GL_VT);
    for (int item = blockIdx.x; item < 1024; item += gridDim.x) {
        const int cg = item & 127, h = (item >> 7) & 3, dir = item >> 9;
        const float dec = gla_stage(lds, p, l, h, cg, dir);
        const size_t ib = ((size_t)dir * 4 + h) * 128 + cg;
        if (tid < 128) DEC[ib * 128 + tid] = dec;
        const int v0 = wid * 16;
        const bf16x8 a0 = *(const LAS bf16x8*)(vT + (v0 + fr) * 72 + fq * 8), a1 = *(const LAS bf16x8*)(vT + (v0 + fr) * 72 + 32 + fq * 8);
#pragma unroll
        for (int dt = 0; dt < 8; ++dt) {
            const bf16x8 b0 = *(const LAS bf16x8*)(klT + (dt * 16 + fr) * 72 + fq * 8), b1 = *(const LAS bf16x8*)(klT + (dt * 16 + fr) * 72 + 32 + fq * 8);
            f32x4 acc = (f32x4){0.f, 0.f, 0.f, 0.f};
            acc = __builtin_amdgcn_mfma_f32_16x16x32_bf16(a0, b0, acc, 0, 0, 0); acc = __builtin_amdgcn_mfma_f32_16x16x32_bf16(a1, b1, acc, 0, 0, 0);
#pragma unroll
            for (int j = 0; j < 4; ++j) KVt[(ib * 128 + v0 + fq * 4 + j) * 128 + dt * 16 + fr] = acc[j];
        }
        __syncthreads();
    }
}
__device__ void gla_g2(const Params& p, int l, int gtid, int gthreads) {
    const float* KVt = (const float*)(p.ws + WS_KVT); const float* DEC = (const float*)(p.ws + WS_DEC); bf16_t* SSt = (bf16_t*)(p.ws + WS_SST);
    for (int idx = gtid; idx < 160 * 4096; idx += gthreads) {
        const int d4 = idx & 31, v = (idx >> 5) & 127, sc = idx >> 12;
        const int seq = sc % 20, dh = sc / 20, h = dh & 3, dir = dh >> 2;
        const bool lat = seq >= 16; const int N = lat ? 16 : 4, cg0 = lat ? 64 + (seq - 16) * 16 : seq * 4, b = lat ? seq - 16 : seq;
        f32x4 S = (f32x4){0.f, 0.f, 0.f, 0.f};
        if (lat) { const float* s0 = p.in[I_SG] + (((((size_t)b * 2 + l) * 2 + dir) * 4 + h) * 128 + d4 * 4) * 128 + v;
#pragma unroll
            for (int e = 0; e < 4; ++e) S[e] = s0[e * 128]; }
        for (int m = 0; m < N; ++m) {
            const int cg = dir ? cg0 + N - 1 - m : cg0 + m; const size_t ib = (size_t)dh * 128 + cg;
            u32x2 w; w.x = cvt_pk_bf16(S[0], S[1]); w.y = cvt_pk_bf16(S[2], S[3]);
            *(u32x2*)(SSt + (ib * 128 + v) * 128 + d4 * 4) = w;
            const f32x4 dec = *(const f32x4*)(DEC + ib * 128 + d4 * 4), kv = *(const f32x4*)(KVt + (ib * 128 + v) * 128 + d4 * 4);
            S = dec * S + kv;
        }
        if (!lat) { float* o = p.out + O_SG + (((((size_t)b * 2 + l) * 2 + dir) * 4 + h) * 128 + d4 * 4) * 128 + v;
#pragma unroll
            for (int e = 0; e < 4; ++e) o[e * 128] = S[e]; }
    }
}
__device__ void gla_g3(LAS unsigned char* lds, const Params& p, int l) {
    const int tid = tid_l(), wid = tid >> 6, lane = tid & 63, fr = lane & 15, fq = lane >> 4;
    const int it = wid & 3, vh = wid >> 2;
    const float* P = (const float*)(p.ws + WS_P); const bf16_t* SSt = (const bf16_t*)(p.ws + WS_SST); bf16_t* Og = (bf16_t*)(p.ws + WS_OGLA);
    LAS bf16_t* qe = (LAS bf16_t*)(lds + GL_QE); LAS bf16_t* ke = (LAS bf16_t*)(lds + GL_KE); LAS bf16_t* vT = (LAS bf16_t*)(lds + GL_VT); LAS float* osum = (LAS float*)(lds + GL_OSUM);
    const float* gn = p.in[I_GNORM] + l * 128;
    for (int item = blockIdx.x; item < 512; item += gridDim.x) {
        const int cg = item & 127, h = item >> 7;
#pragma unroll 1
        for (int dir = 0; dir < 2; ++dir) {
            gla_stage(lds, p, l, h, cg, dir);
            bf16x8 qf[4];
#pragma unroll
            for (int kc = 0; kc < 4; ++kc) qf[kc] = *(const LAS bf16x8*)(qe + (it * 16 + fr) * 136 + kc * 32 + fq * 8);
            f32x4 o[4];
#pragma unroll
            for (int vt = 0; vt < 4; ++vt) o[vt] = (f32x4){0.f, 0.f, 0.f, 0.f};
            const bf16_t* ss = SSt + (((size_t)dir * 4 + h) * 128 + cg) * 16384;
#pragma unroll
            for (int vt = 0; vt < 4; ++vt) { const int v0 = (vh * 4 + vt) * 16;
#pragma unroll
                for (int kc = 0; kc < 4; ++kc) { const bf16x8 sa = *(const bf16x8*)(ss + (size_t)(v0 + fr) * 128 + kc * 32 + fq * 8);
                    o[vt] = __builtin_amdgcn_mfma_f32_16x16x32_bf16(sa, qf[kc], o[vt], 0, 0, 0); } }
#pragma unroll
            for (int jp = 0; jp < 2; ++jp) {
                if (2 * jp <= it) {
                    f32x4 s[2];
#pragma unroll
                    for (int e = 0; e < 2; ++e) { const int jt = 2 * jp + e; s[e] = (f32x4){0.f, 0.f, 0.f, 0.f};
                        if (jt <= it) {
#pragma unroll
                            for (int kc = 0; kc < 4; ++kc) { const bf16x8 ka = *(const LAS bf16x8*)(ke + (jt * 16 + fr) * 136 + kc * 32 + fq * 8);
                                s[e] = __builtin_amdgcn_mfma_f32_16x16x32_bf16(ka, qf[kc], s[e], 0, 0, 0); }
                            if (jt == it) {
#pragma unroll
                                for (int j = 0; j < 4; ++j) if (fq * 4 + j > fr) s[e][j] = 0.f; }
                        } }
                    u32x4 w; w.x = cvt_pk_bf16(s[0][0], s[0][1]); w.y = cvt_pk_bf16(s[0][2], s[0][3]); w.z = cvt_pk_bf16(s[1][0], s[1][1]); w.w = cvt_pk_bf16(s[1][2], s[1][3]);
                    const bf16x8 pb = __builtin_bit_cast(bf16x8, w);
#pragma unroll
                    for (int vt = 0; vt < 4; ++vt) { const int v0 = (vh * 4 + vt) * 16;
                        const LAS bf16_t* vp = vT + (v0 + fr) * 72 + jp * 32 + fq * 4;
                        const u32x2 va = *(const LAS u32x2*)vp, vb = *(const LAS u32x2*)(vp + 16);
                        u32x4 vw; vw.x = va.x; vw.y = va.y; vw.z = vb.x; vw.w = vb.y;
                        o[vt] = __builtin_amdgcn_mfma_f32_16x16x32_bf16(__builtin_bit_cast(bf16x8, vw), pb, o[vt], 0, 0, 0); }
                }
            }
            const int i = it * 16 + fr, tl = dir ? 63 - i : i;
#pragma unroll
            for (int vt = 0; vt < 4; ++vt) { LAS f32x4* op = (LAS f32x4*)(osum + tl * 132 + (vh * 4 + vt) * 16 + fq * 4);
                if (dir == 0) *op = o[vt]; else *op = *op + o[vt]; }
            __syncthreads();
        }
#pragma unroll 1
        for (int r = 0; r < 8; ++r) { const int tl = wid * 8 + r, tok = cg * 64 + tl;
            const float x0 = osum[tl * 132 + lane], x1 = osum[tl * 132 + 64 + lane];
            const float ssq = wave_sum(x0 * x0 + x1 * x1); const float rs = rsqrtf(ssq * (1.0f / 128.0f) + 1e-6f);
            const float* gg = P + (size_t)tok * PW + P_GG + h * 128;
            Og[(size_t)tok * 512 + h * 128 + lane] = f2bf(x0 * rs * gn[lane] * siluf_(gg[lane]));
            Og[(size_t)tok * 512 + h * 128 + 64 + lane] = f2bf(x1 * rs * gn[64 + lane] * siluf_(gg[64 + lane])); }
        __syncthreads();
    }
}

__device__ __forceinline__ float dpp_sum8(float x) {
    int xi = __builtin_bit_cast(int, x);
    x += __builtin_bit_cast(float, __builtin_amdgcn_update_dpp(0, xi, 0xB1, 0xf, 0xf, true));
    xi = __builtin_bit_cast(int, x);
    x += __builtin_bit_cast(float, __builtin_amdgcn_update_dpp(0, xi, 0x4E, 0xf, 0xf, true));
    xi = __builtin_bit_cast(int, x);
    x += __builtin_bit_cast(float, __builtin_amdgcn_update_dpp(0, xi, 0x141, 0xf, 0xf, true));
    return x;
}
__device__ void rwkv_scan_job(LAS unsigned char* lds, const Params& p, int l, int job) {
    const int tid = tid_l(), wid = tid >> 6, lane = tid & 63, kp = lane & 7, v = wid * 8 + (lane >> 3);
    const bool lat = job < 64; const int jj = lat ? job : job - 64;
    const int dir = jj & 1, h = (jj >> 1) & 7, b = jj >> 4;
    const int T = lat ? 1024 : 256, tok0 = lat ? NCTX + b * 1024 : b * 256;
    const float* scan = (const float*)(p.ws + WS_SCAN);
    float* yout = (float*)(p.ws + (dir ? WS_YB : WS_YF));
    LAS float* buf = (LAS float*)lds;
    f32x4 s0 = (f32x4){0.f, 0.f, 0.f, 0.f}, s1 = (f32x4){0.f, 0.f, 0.f, 0.f};
    if (lat) { const float* sp = p.in[I_SR] + ((((((size_t)b * 2 + l) * 2 + dir) * 8 + h) * 64 + v) * 64) + kp * 8; s0 = *(const f32x4*)sp; s1 = *(const f32x4*)(sp + 4); }
    const int nch = T / 16;
    f32x4 pre[4];
    auto gload = [&](int c) {
#pragma unroll
        for (int r = 0; r < 4; ++r) { const int idx = tid + 512 * r;
            if (idx < 1792) { const int ss = idx / 112, e = idx - ss * 112; const int st = c * 16 + ss; const int tok = dir ? tok0 + T - 1 - st : tok0 + st;
                pre[r] = *(const f32x4*)(scan + ((size_t)tok * 8 + h) * SB_STRIDE + e * 4); } }
    };
    auto lstore = [&](int bsel) {
#pragma unroll
        for (int r = 0; r < 4; ++r) { const int idx = tid + 512 * r; if (idx < 1792) *(LAS f32x4*)(buf + bsel * 7168 + idx * 4) = pre[r]; }
    };
    gload(0); lstore(0);
    __syncthreads();
    const int woff = dir ? 384 : 320;
    for (int c = 0; c < nch; ++c) {
        if (c + 1 < nch) gload(c + 1);
        const LAS float* bb = buf + (c & 1) * 7168;
#pragma unroll 4
        for (int ss = 0; ss < 16; ++ss) {
            const LAS float* row = bb + ss * 448 + kp * 8;
            const f32x4 r0 = *(const LAS f32x4*)(row), r1 = *(const LAS f32x4*)(row + 4);
            const f32x4 k0 = *(const LAS f32x4*)(row + 64), k1 = *(const LAS f32x4*)(row + 68);
            const f32x4 kap0 = *(const LAS f32x4*)(row + 192), kap1 = *(const LAS f32x4*)(row + 196);
            const f32x4 ka0 = *(const LAS f32x4*)(row + 256), ka1 = *(const LAS f32x4*)(row + 260);
            const f32x4 w0 = *(const LAS f32x4*)(row + woff), w1 = *(const LAS f32x4*)(row + woff + 4);
            const float vv = bb[ss * 448 + 128 + v];
            const f32x4 t0 = s0 * kap0 + s1 * kap1;
            const float sk = dpp_sum8((t0[0] + t0[1]) + (t0[2] + t0[3]));
            s0 = s0 * w0 + (k0 * vv - ka0 * sk); s1 = s1 * w1 + (k1 * vv - ka1 * sk);
            const f32x4 t1 = s0 * r0 + s1 * r1;
            const float y = dpp_sum8((t1[0] + t1[1]) + (t1[2] + t1[3]));
            if (kp == 0) { const int st = c * 16 + ss; const int tok = dir ? tok0 + T - 1 - st : tok0 + st; yout[(size_t)tok * 512 + h * 64 + v] = y; }
        }
        if (c + 1 < nch) lstore((c + 1) & 1);
        __syncthreads();
    }
    if (!lat) { float* sp = p.out + O_SR + ((((((size_t)b * 2 + l) * 2 + dir) * 8 + h) * 64 + v) * 64) + kp * 8; *(f32x4*)sp = s0; *(f32x4*)(sp + 4) = s1; }
}
__device__ void rwkv_scan_phase(LAS unsigned char* lds, const Params& p, int l) {
    const int wg = blockIdx.x, nwg = gridDim.x;
    for (int j = 0; j < 320; ++j) {
        const int owner = (j < 64) ? (j % nwg) : (nwg > 64 ? 64 + (j - 64) % (nwg - 64) : j % nwg);
        if (owner == wg) rwkv_scan_job(lds, p, l, j);
    }
}
__device__ void rwkv_post(const Params& p, int l, int gwave, int nwave) {
    const int lane = tid_l() & 63;
    const float* scan = (const float*)(p.ws + WS_SCAN); const float* yf = (const float*)(p.ws + WS_YF); const float* yb = (const float*)(p.ws + WS_YB); const float* gout = (const float*)(p.ws + WS_GOUT);
    bf16_t* Y = (bf16_t*)(p.ws + WS_YRW);
    const float* rho = p.in[I_RBONUS] + l * 512; const float* lw = p.in[I_RLNW] + l * 512; const float* lb = p.in[I_RLNB] + l * 512;
    for (int it = gwave; it < NTOK * 8; it += nwave) {
        const int h = it & 7, tok = it >> 3; const int c = h * 64 + lane;
        const float* sb = scan + (size_t)it * SB_STRIDE;
        const float bs = wave_sum(sb[lane] * sb[64 + lane] * rho[c]);
        const float y = yf[(size_t)tok * 512 + c] + yb[(size_t)tok * 512 + c] + bs * sb[128 + lane];
        const float mean = wave_sum(y) * (1.0f / 64.0f); const float xc = y - mean;
        const float var = wave_sum(xc * xc) * (1.0f / 64.0f);
        const float o = (xc * rsqrtf(var + 64e-5f) * lw[c] + lb[c]) * gout[(size_t)tok * 512 + c];
        Y[(size_t)tok * 512 + c] = f2bf(o);
    }
}

__device__ void conv_act_phase(const Params& p, int l, int gtid, int gthreads) {
    const bf16_t* U = (const bf16_t*)(p.ws + WS_U); bf16_t* A = (bf16_t*)(p.ws + WS_ABF);
    const float* cw = p.in[I_FCW] + (size_t)l * 3 * FU; const float* cb = p.in[I_FCB] + (size_t)l * FU;
    for (int item = gtid; item < 256 * 688; item += gthreads) {
        const int vc = item % 688, tb = item / 688; const int c0 = vc * 8, t0 = tb * 32;
        float wv[3][8], wg[3][8], bv[8], bg[8];
#pragma unroll
        for (int e = 0; e < 8; ++e) { bv[e] = cb[c0 + e]; bg[e] = cb[FH + c0 + e];
#pragma unroll
            for (int k = 0; k < 3; ++k) { wv[k][e] = cw[k * FU + c0 + e]; wg[k][e] = cw[k * FU + FH + c0 + e]; } }
        const int T = t0 < NCTX ? 256 : 1024; const int tin = t0 < NCTX ? (t0 & 255) : ((t0 - NCTX) & 1023);
        u32x4 pv, pg, cv, cgv, nv, ng; const u32x4 z = (u32x4){0u, 0u, 0u, 0u};
        pv = tin > 0 ? *(const u32x4*)(U + (size_t)(t0 - 1) * FU + c0) : z; pg = tin > 0 ? *(const u32x4*)(U + (size_t)(t0 - 1) * FU + FH + c0) : z;
        cv = *(const u32x4*)(U + (size_t)t0 * FU + c0); cgv = *(const u32x4*)(U + (size_t)t0 * FU + FH + c0);
#pragma unroll 1
        for (int i = 0; i < 32; ++i) {
            const int t = t0 + i; const bool hn = (tin + i) < T - 1;
            nv = hn ? *(const u32x4*)(U + (size_t)(t + 1) * FU + c0) : z; ng = hn ? *(const u32x4*)(U + (size_t)(t + 1) * FU + FH + c0) : z;
            float ov[8];
#pragma unroll
            for (int e = 0; e < 8; ++e) { const int wi = e >> 1; const bool hi = e & 1;
                auto ex = [&](const u32x4& q) { const unsigned w = q[wi]; return __uint_as_float(hi ? (w & 0xffff0000u) : (w << 16)); };
                const float val = wv[0][e] * ex(pv) + wv[1][e] * ex(cv) + wv[2][e] * ex(nv) + bv[e];
                const float gat = wg[0][e] * ex(pg) + wg[1][e] * ex(cgv) + wg[2][e] * ex(ng) + bg[e];
                ov[e] = siluf_(gat) * val; }
            u32x4 w; w.x = cvt_pk_bf16(ov[0], ov[1]); w.y = cvt_pk_bf16(ov[2], ov[3]); w.z = cvt_pk_bf16(ov[4], ov[5]); w.w = cvt_pk_bf16(ov[6], ov[7]);
            *(u32x4*)(A + (size_t)t * FH + c0) = w;
            pv = cv; pg = cgv; cv = nv; cgv = ng;
        }
    }
}

#ifndef PH_MASK
#define PH_MASK 0xFFFFFFFFu
#endif
#define PH(b) if (PH_MASK & (1u << (b)))
__device__ __forceinline__ const Params& PPf() { const Params* q = (const Params*)(const void*)__builtin_amdgcn_kernarg_segment_ptr(); asm volatile("" : "+s"(q)); return *q; }
#define PP PPf()
__global__ void __launch_bounds__(512, 2) fwd_megakernel(Params p_unused) {
    extern __shared__ __attribute__((aligned(16))) unsigned char shm[];
    LAS unsigned char* lds = (LAS unsigned char*)shm;
    cg::grid_group grid = cg::this_grid();
#define WGI ((int)blockIdx.x)
#define NWG ((int)gridDim.x)
#define GTID ((int)(blockIdx.x * 512 + tid_l()))
#define GTHREADS ((int)(gridDim.x * 512))
#define GWAVE ((int)(blockIdx.x * 8 + (tid_l() >> 6)))
#define NWAVE ((int)(gridDim.x * 8))
    PH(0) mod_phase(PP, (LAS float*)lds, WGI, NWG);
#pragma unroll 1
    for (int l = 0; l < 2; ++l) {
        PH(1) { const Params& p = PP; bf16_t* W = (bf16_t*)(p.ws + WS_W);
            convert_job((LAS float*)lds, p.in[I_WIN] + (size_t)l * 2048 * 11616, (bf16_t*)((char*)W + W_IN), 2048, 11616, NIN_PAD, 1, WGI, NWG);
            convert_job((LAS float*)lds, p.in[I_WBRA] + (size_t)l * 1024 * 2048, (bf16_t*)((char*)W + W_BRA), 1024, 2048, 2048, 0, (WGI + 64) % NWG, NWG);
            convert_job((LAS float*)lds, p.in[I_WBRG] + (size_t)l * 512 * 2048, (bf16_t*)((char*)W + W_BRG), 512, 2048, 2048, 0, (WGI + 128) % NWG, NWG);
            convert_job((LAS float*)lds, p.in[I_WBRR] + (size_t)l * 512 * 2048, (bf16_t*)((char*)W + W_BRR), 512, 2048, 2048, 0, (WGI + 192) % NWG, NWG);
            convert_job((LAS float*)lds, p.in[I_WOUT] + (size_t)l * 2048 * 2048, (bf16_t*)((char*)W + W_OUT), 2048, 2048, 2048, 0, WGI, NWG);
            convert_lr(p, l, (bf16_t*)((char*)W + W_LR), GTID, GTHREADS); }
        if (l == 0) grid.sync();
        PH(2) { const Params& p = PP; norm_phase(p, l, l == 0, p.in[I_NMIX] + l * DM, 0, 1, GWAVE, NWAVE); }
        grid.sync();
        PH(3) { const Params& p = PP; EpiIn E; E.P = (float*)(p.ws + WS_P); E.G = (bf16_t*)(p.ws + WS_G); run_gemm(lds, (const bf16_t*)(p.ws + WS_H), (const bf16_t*)(p.ws + WS_W + W_IN), NIN_PAD, 2048, E); }
        grid.sync();
        PH(4) prep_phase(PP, l, GWAVE, NWAVE);
        grid.sync();
        PH(5) attn_phase(PP);
        PH(6) gla_g1(lds, PP, l);
        PH(7) { const Params& p = PP; EpiLr E; E.scan = (float*)(p.ws + WS_SCAN); E.gout = (float*)(p.ws + WS_GOUT); E.w0 = p.in[I_RW0] + l * 1024; E.a0 = p.in[I_RA0] + l * 512; E.alpha = p.in[I_RALPHA] + l * 512;
          run_gemm(lds, (const bf16_t*)(p.ws + WS_ALR), (const bf16_t*)(p.ws + WS_W + W_LR), 2048, 384, E); }
        grid.sync();
        PH(8) gla_g2(PP, l, GTID, GTHREADS);
        PH(9) rwkv_scan_phase(lds, PP, l);
        grid.sync();
        PH(10) gla_g3(lds, PP, l);
        PH(11) rwkv_post(PP, l, GWAVE, NWAVE);
        grid.sync();
        PH(12) { const Params& p = PP; EpiBr E; E.Mb = (float*)(p.ws + WS_MBUF); E.merged = (bf16_t*)(p.ws + WS_MERGED); E.G = (const bf16_t*)(p.ws + WS_G);
          E.mode = 0; run_gemm(lds, (const bf16_t*)(p.ws + WS_OATT), (const bf16_t*)(p.ws + WS_W + W_BRA), 2048, 1024, E); }
        PH(12) { const Params& p = PP; EpiBr E; E.Mb = (float*)(p.ws + WS_MBUF); E.merged = (bf16_t*)(p.ws + WS_MERGED); E.G = (const bf16_t*)(p.ws + WS_G);
          E.mode = 1; run_gemm(lds, (const bf16_t*)(p.ws + WS_OGLA), (const bf16_t*)(p.ws + WS_W + W_BRG), 2048, 512, E); }
        PH(12) { const Params& p = PP; EpiBr E; E.Mb = (float*)(p.ws + WS_MBUF); E.merged = (bf16_t*)(p.ws + WS_MERGED); E.G = (const bf16_t*)(p.ws + WS_G);
          E.mode = 2; run_gemm(lds, (const bf16_t*)(p.ws + WS_YRW), (const bf16_t*)(p.ws + WS_W + W_BRR), 2048, 512, E); }
        grid.sync();
        PH(13) { const Params& p = PP; EpiRes E; E.x = p.out + O_X; E.gate = (const float*)(p.ws + WS_MOD) + (size_t)l * 5 * 12288 + 2 * 2048;
          run_gemm(lds, (const bf16_t*)(p.ws + WS_MERGED), (const bf16_t*)(p.ws + WS_W + W_OUT), 2048, 2048, E); }
        grid.sync();
        PH(16) { const Params& p = PP; bf16_t* W = (bf16_t*)(p.ws + WS_W);
            convert_job((LAS float*)lds, p.in[I_FUP] + (size_t)l * 2048 * FU, (bf16_t*)((char*)W + W_UP), 2048, FU, FU, 0, WGI, NWG);
            convert_job((LAS float*)lds, p.in[I_FDOWN] + (size_t)l * FH * 2048, (bf16_t*)((char*)W + W_DOWN), FH, 2048, 2048, 0, WGI, NWG); }
        PH(17) { const Params& p = PP; norm_phase(p, l, false, p.in[I_NFFN] + l * DM, 3, 4, GWAVE, NWAVE); }
        grid.sync();
        PH(15) { const Params& p = PP; EpiUp E; E.U = (bf16_t*)(p.ws + WS_U); run_gemm(lds, (const bf16_t*)(p.ws + WS_H), (const bf16_t*)(p.ws + WS_W + W_UP), FU, 2048, E); }
        grid.sync();
        PH(14) conv_act_phase(PP, l, GTID, GTHREADS);
        grid.sync();
        PH(18) { const Params& p = PP; EpiRes E; E.x = p.out + O_X; E.gate = (const float*)(p.ws + WS_MOD) + (size_t)l * 5 * 12288 + 5 * 2048;
          run_gemm(lds, (const bf16_t*)(p.ws + WS_ABF), (const bf16_t*)(p.ws + WS_W + W_DOWN), 2048, FH, E); }
        grid.sync();
    }
}

extern "C" void kernel_launch(void* const* d_in, const int* in_sizes, int n_in, void* d_out, int out_size, void* d_ws, size_t ws_size, hipStream_t stream) {
    static int grid_blocks = 0;
    if (grid_blocks == 0) {
        if (n_in != 37 || ws_size < WS_END) { fprintf(stderr, "kernel_launch: unexpected n_in %d / ws %zu (need %zu)\n", n_in, ws_size, (size_t)WS_END); grid_blocks = -1; return; }
        int dev = 0, cus = 0, per_cu = 0;
        hipGetDevice(&dev);
        hipDeviceGetAttribute(&cus, hipDeviceAttributeMultiprocessorCount, dev);
        hipFuncSetAttribute((const void*)fwd_megakernel, hipFuncAttributeMaxDynamicSharedMemorySize, LDS_BYTES);
        hipOccupancyMaxActiveBlocksPerMultiprocessor(&per_cu, (const void*)fwd_megakernel, 512, LDS_BYTES);
        if (per_cu < 1) { fprintf(stderr, "kernel_launch: occupancy query says %d blocks per CU\n", per_cu); grid_blocks = -1; return; }
        grid_blocks = cus;
    }
    if (grid_blocks < 0) return;
    Params p{};
    for (int i = 0; i < 37; ++i) p.in[i] = (const float*)d_in[i];
    p.out = (float*)d_out; p.ws = (unsigned char*)d_ws;
    void* args[] = {&p};
    hipError_t e = hipLaunchCooperativeKernel((void*)fwd_megakernel, dim3(grid_blocks), dim3(512), args, LDS_BYTES, stream);
    if (e != hipSuccess) fprintf(stderr, "cooperative launch failed: %s (grid %d)\n", hipGetErrorString(e), grid_blocks);
}
```

```cpp
#include <hip/hip_runtime.h>
#include <hip/hip_cooperative_groups.h>
#include <cstdio>
namespace cg = cooperative_groups;
__device__ __forceinline__ int tid_l() { int t = (int)threadIdx.x; asm volatile("" : "+v"(t)); __builtin_assume(t >= 0 && t < 512); return t; }
namespace pg8 {
#define PG8_LAS __attribute__((address_space(3)))
typedef unsigned short bf16_t;
typedef short bf16x8 __attribute__((ext_vector_type(8)));
typedef float f32x4 __attribute__((ext_vector_type(4)));
typedef unsigned u32x4 __attribute__((ext_vector_type(4)));
constexpr int BM = 256, BK = 64, HALF = 128, HTB = HALF * BK * 2  , STAGE_BYTES = 8 * HTB, NXCD = 8, WGM = 8;

__host__ __device__ __forceinline__ int lds_byte(int r, int c) { const int st = (r >> 4) * 2 + (c >> 5), rr = r & 15, cc = c & 31, ob = rr * 64 + cc * 2; return st * 1024 + (ob ^ (((ob >> 9) & 1) << 5)); }
__host__ __device__ __forceinline__ void stage_rc(int b, int& R, int& C) { const int st = b / 1024, sb = b % 1024, swz = sb ^ (((sb >> 9) & 1) << 5); R = (st >> 1) * 16 + swz / 64; C = (st & 1) * 32 + (swz % 64) / 2; }
__host__ __device__ __forceinline__ int perm32(int rho) { const int n = rho >> 4, i = rho & 15; return 8 * (i >> 2) + 4 * n + (i & 3); }

struct Unit { int pm, pn; };
struct Gemm { const bf16_t* A; const bf16_t* Bt; int M, N, K; };

struct StaticOrder {
    int nM, nN, nwg, G, c;
    __host__ __device__ void init(int M, int N, int G_, int c_) { nM = M / BM; nN = N / BM; nwg = nM * nN; G = G_; c = c_; }
    __device__ bool next(int i, Unit& u) const {
        const long L = (long)i * G + c; if (L >= nwg) return false;
        int wgid = (int)L; { const int q = nwg / NXCD, r = nwg % NXCD, xcd = wgid % NXCD, off = wgid / NXCD; wgid = (xcd < r ? xcd * (q + 1) : r * (q + 1) + (xcd - r) * q) + off; }
        const int nig = WGM * nN, gid = wgid / nig, fm = gid * WGM, gsz = (nM - fm) < WGM ? (nM - fm) : WGM;
        u.pm = __builtin_amdgcn_readfirstlane(fm + ((wgid % nig) % gsz)); u.pn = __builtin_amdgcn_readfirstlane((wgid % nig) / gsz); return true;
    }
    __device__ __forceinline__ void a_ready(const Unit&) const {}
    __device__ __forceinline__ void done(const Unit&) const {}
};
__device__ __forceinline__ unsigned cvt_pk_bf16(float lo, float hi) { unsigned r; asm volatile("s_nop 1\n\tv_cvt_pk_bf16_f32 %0, %1, %2" : "=v"(r) : "v"(lo), "v"(hi));     return r; }
typedef float f32x2 __attribute__((ext_vector_type(2)));
template <class Epi, class Sched, bool STAMP = false>
__device__ __forceinline__ void gemm_phase(PG8_LAS unsigned char* lds, const Gemm g, const Sched& S, const Epi& E, unsigned long long* stamps) {
    const int tid = tid_l(), wid = __builtin_amdgcn_readfirstlane(tid >> 6), lane = tid & 63, wr = wid >> 2, wc = wid & 3, fr = lane & 15, fq = lane >> 4;
    const int K = g.K, nt = K / BK;
    int ts_lo = 0, ts_hi = 0, nts = 0; const unsigned long long rt_entry = STAMP ? (unsigned long long)wall_clock64() : 0ull;
#define PG8_STAMP() do { if (STAMP && wid == 0 && nts < 64) { const unsigned long long _c = (unsigned long long)clock64(); \
        ts_lo = (lane == nts) ? (int)(unsigned)_c : ts_lo; ts_hi = (lane == nts) ? (int)(unsigned)(_c >> 32) : ts_hi; ++nts; } } while (0)
    PG8_STAMP();
    unsigned voffA[2], voffB[2];
#pragma unroll
    for (int i = 0; i < 2; ++i) { int R, C; stage_rc(tid * 16 + i * 8192, R, C); const int Rb = Epi::PERM ? ((R & ~31) + perm32(R & 31)) : R;
        voffA[i] = (unsigned)(R * K + C) * 2u; voffB[i] = (unsigned)(Rb * K + C) * 2u; }
    const size_t kstep = (size_t)(BK * 2);
    const size_t hstep = (size_t)HALF * K * 2;
    const size_t tstep = 2 * hstep;
    const unsigned ldsw = (unsigned)wid * 1024u;
    const int aoff = lds_byte(wr * 64 + fr, fq * 8), boff = lds_byte(wc * 32 + fr, fq * 8);
#define PG8_SA(b, h) (((b) * 2 + (h)) * HTB)
#define PG8_SB(b, h) ((4 + (b) * 2 + (h)) * HTB)
#define PG8_STAGE(bufoff, gbase, voff) do { _Pragma("unroll") for (int _i = 0; _i < 2; ++_i) \
        __builtin_amdgcn_global_load_lds((const unsigned*)((const char*)(gbase) + (voff)[_i]), (PG8_LAS unsigned*)(lds + (bufoff) + ldsw + _i * 8192), 16, 0, 0); } while (0)
#define PG8_LDA(dst, b, h) do { _Pragma("unroll") for (int m = 0; m < 4; ++m) _Pragma("unroll") for (int k = 0; k < 2; ++k) dst[m][k] = *(const PG8_LAS bf16x8*)(lds + PG8_SA(b, h) + aoff + m * 2048 + k * 1024); } while (0)
#define PG8_LDB(dst, b, h) do { _Pragma("unroll") for (int n = 0; n < 2; ++n) _Pragma("unroll") for (int k = 0; k < 2; ++k) dst[n][k] = *(const PG8_LAS bf16x8*)(lds + PG8_SB(b, h) + boff + n * 2048 + k * 1024); } while (0)
#define PG8_MMA(ai, bj, At, Bt) do { __builtin_amdgcn_s_setprio(1); _Pragma("unroll") for (int m = 0; m < 4; ++m) _Pragma("unroll") for (int n = 0; n < 2; ++n) _Pragma("unroll") for (int k = 0; k < 2; ++k) \
        acc[ai][bj][m][n] = __builtin_amdgcn_mfma_f32_16x16x32_bf16(Bt[n][k], At[m][k], acc[ai][bj][m][n], 0, 0, 0); __builtin_amdgcn_s_setprio(0); } while (0)
#define PG8_WAIT_V(n) asm volatile("s_waitcnt vmcnt(" #n ")" ::: "memory")
#define PG8_WAIT_L(n) asm volatile("s_waitcnt lgkmcnt(" #n ")" ::: "memory")
#define PG8_BAR __builtin_amdgcn_s_barrier()
#define PG8_SCHED __builtin_amdgcn_sched_barrier(0)
    Unit cur, nxt; int ui = 0;
    if (!S.next(0, cur)) return;
    f32x4 acc[2][2][4][2];
#pragma unroll
    for (int a = 0; a < 2; ++a)
#pragma unroll
        for (int b = 0; b < 2; ++b)
#pragma unroll
            for (int m = 0; m < 4; ++m)
#pragma unroll
                for (int n = 0; n < 2; ++n) acc[a][b][m][n] = (f32x4){0.f, 0.f, 0.f, 0.f};
    bf16x8 At[4][2], B0[2][2], B1[2][2];
    const char* cA = (const char*)g.A + (size_t)cur.pm * tstep; const char* cB = (const char*)g.Bt + (size_t)cur.pn * tstep;
    S.a_ready(cur);
    PG8_STAGE(PG8_SB(0, 0), cB, voffB); PG8_STAGE(PG8_SA(0, 0), cA, voffA); PG8_STAGE(PG8_SB(0, 1), cB + hstep, voffB); PG8_STAGE(PG8_SA(0, 1), cA + hstep, voffA);
    if (wr == 1) PG8_BAR;
    PG8_WAIT_V(4); PG8_BAR;
    PG8_STAGE(PG8_SB(1, 0), cB + kstep, voffB); PG8_STAGE(PG8_SA(1, 0), cA + kstep, voffA); PG8_STAGE(PG8_SB(1, 1), cB + hstep + kstep, voffB);
    PG8_WAIT_V(6); PG8_BAR;
    PG8_STAMP();
    for (;;) {
        const bool has_next = S.next(ui + 1, nxt);
        const char* nA = has_next ? (const char*)g.A + (size_t)nxt.pm * tstep : cA; const char* nB = has_next ? (const char*)g.Bt + (size_t)nxt.pn * tstep : cB;
        for (int t = 0; t < nt; t += 2) {
            const bool last = (t == nt - 2);
            const char* a1 = cA + (size_t)(t + 1) * kstep;
            const char* a2 = last ? nA : cA + (size_t)(t + 2) * kstep; const char* b2 = last ? nB : cB + (size_t)(t + 2) * kstep;
            const char* a3 = a2 + kstep; const char* b3 = b2 + kstep;
            if (last && has_next) S.a_ready(nxt);
            if constexpr (Epi::HAS_MID) { if (E.mid_at(t)) E.mid(acc, cur, t, wr, wc, fr, fq); }
            PG8_LDB(B0, 0, 0); PG8_SCHED; PG8_LDA(At, 0, 0); PG8_STAGE(PG8_SA(1, 1), a1 + hstep, voffA);
            PG8_WAIT_L(8); PG8_BAR; PG8_WAIT_L(0); PG8_MMA(0, 0, At, B0); PG8_BAR; PG8_SCHED;
            PG8_LDB(B1, 0, 1); PG8_STAGE(PG8_SB(0, 0), b2, voffB);
            PG8_BAR; PG8_WAIT_L(0); PG8_MMA(0, 1, At, B1); PG8_BAR;
            PG8_LDA(At, 0, 1); PG8_STAGE(PG8_SA(0, 0), a2, voffA);
            PG8_BAR; PG8_WAIT_L(0); PG8_MMA(1, 0, At, B0); PG8_BAR; PG8_SCHED;
            PG8_STAGE(PG8_SB(0, 1), b2 + hstep, voffB);
            PG8_WAIT_V(6); PG8_BAR; PG8_MMA(1, 1, At, B1); PG8_BAR;
            PG8_LDB(B0, 1, 0); PG8_SCHED; PG8_LDA(At, 1, 0); PG8_STAGE(PG8_SA(0, 1), a2 + hstep, voffA);
            PG8_WAIT_L(8); PG8_BAR; PG8_WAIT_L(0); PG8_MMA(0, 0, At, B0); PG8_BAR; PG8_SCHED;
            PG8_LDB(B1, 1, 1); PG8_STAGE(PG8_SB(1, 0), b3, voffB);
            PG8_BAR; PG8_WAIT_L(0); PG8_MMA(0, 1, At, B1); PG8_BAR;
            PG8_LDA(At, 1, 1); PG8_STAGE(PG8_SA(1, 0), a3, voffA);
            PG8_BAR; PG8_WAIT_L(0); PG8_MMA(1, 0, At, B0); PG8_BAR; PG8_SCHED;
            PG8_STAGE(PG8_SB(1, 1), b3 + hstep, voffB);
            PG8_WAIT_V(6); PG8_BAR; PG8_MMA(1, 1, At, B1); PG8_BAR;
        }
        PG8_STAMP();
        if constexpr (!Epi::AFTER_DRAIN) { E(acc, cur, wr, wc, fr, fq); S.done(cur); }
        PG8_STAMP();
        if (!has_next) break;
#pragma unroll
        for (int a = 0; a < 2; ++a)
#pragma unroll
            for (int b = 0; b < 2; ++b)
#pragma unroll
                for (int m = 0; m < 4; ++m)
#pragma unroll
                    for (int n = 0; n < 2; ++n) acc[a][b][m][n] = (f32x4){0.f, 0.f, 0.f, 0.f};
        cur = nxt; cA = nA; cB = nB; ++ui;
    }
    PG8_WAIT_V(0);
    if (wr == 0) PG8_BAR;
    PG8_BAR;
    if constexpr (Epi::AFTER_DRAIN) { E.fused(acc, cur, wr, wc, fr, fq, lds, wid, lane); S.done(cur); }
    PG8_STAMP();
    if (STAMP && wid == 0) { stamps[lane] = lane < nts ? (((unsigned long long)(unsigned)ts_hi << 32) | (unsigned)ts_lo) : 0ull;
        if (lane == 62) stamps[62] = rt_entry; if (lane == 63) stamps[63] = (unsigned long long)wall_clock64(); }
#undef PG8_STAMP
#undef PG8_SA
#undef PG8_SB
#undef PG8_STAGE
#undef PG8_LDA
#undef PG8_LDB
#undef PG8_MMA
#undef PG8_WAIT_V
#undef PG8_WAIT_L
#undef PG8_BAR
#undef PG8_SCHED
}
}

#define LAS __attribute__((address_space(3)))
typedef unsigned short bf16_t;
typedef short bf16x8 __attribute__((ext_vector_type(8)));
typedef short bf16x4 __attribute__((ext_vector_type(4)));
typedef float f32x4 __attribute__((ext_vector_type(4)));
typedef float f32x2 __attribute__((ext_vector_type(2)));
typedef unsigned u32x4 __attribute__((ext_vector_type(4)));
typedef unsigned u32x2 __attribute__((ext_vector_type(2)));
using pg8::cvt_pk_bf16;

constexpr int DM = 2048, NTOK = 8192, NCTX = 4096;
constexpr int PW = 5888;
constexpr int P_AQ = 0, P_AK = 1024, P_AV = 1280, P_GQ = 1536, P_GK = 2048, P_GV = 2560, P_GG = 3072, P_GAD = 3584, P_RW = 3840;
constexpr int GW = 6144;
constexpr int NIN_PAD = 12032;
constexpr int FH = 5504, FU = 11008;
constexpr int SB_STRIDE = 448;
constexpr int LDS_BYTES = 147456;

constexpr size_t O_X = 0, O_CK = 16777216, O_CV = 18874368, O_SG = 20971520, O_SR = 25165824;

constexpr size_t MBy = 1048576;
constexpr size_t WS_W = 0;
constexpr size_t W_IN = 0, W_BRA = 49283072, W_BRG = 53477376, W_BRR = 55574528, W_OUT = 57671680, W_LR = 66060288;
constexpr size_t W_UP = 0, W_DOWN = 45088768;
constexpr size_t WS_A = 68 * MBy;
constexpr size_t WS_P = WS_A, WS_G = WS_A + 192937984, WS_U = WS_A;
constexpr size_t WS_B = WS_A + 280 * MBy;
constexpr size_t WS_SCAN = WS_B, WS_ALR = WS_B + 112 * MBy, WS_GOUT = WS_B + 118 * MBy;
constexpr size_t WS_ABF = WS_B, WS_MBUF = WS_B + 86 * MBy;
constexpr size_t WS_C = WS_B + 150 * MBy;
constexpr size_t WS_KVT = WS_C, WS_SST = WS_C + 64 * MBy, WS_DEC = WS_C + 96 * MBy, WS_YF = WS_C + 97 * MBy, WS_YB = WS_C + 113 * MBy;
constexpr size_t WS_D = WS_C + 129 * MBy;
constexpr size_t WS_H = WS_D, WS_MERGED = WS_D, WS_QB = WS_D + 32 * MBy, WS_KC = WS_D + 48 * MBy, WS_VTC = WS_D + 50 * MBy, WS_KL = WS_D + 52 * MBy, WS_VTL = WS_D + 55 * MBy,
                 WS_OATT = WS_D + 58 * MBy, WS_OGLA = WS_D + 74 * MBy, WS_YRW = WS_D + 82 * MBy, WS_MOD = WS_D + 90 * MBy;
constexpr size_t WS_BAR = WS_D + 90 * MBy + 786432;
constexpr size_t WS_GST = WS_D + 91 * MBy;
constexpr size_t WS_END = WS_GST + 48 * MBy;

struct Params { const float* in[37]; float* out; unsigned char* ws; };
typedef const __attribute__((address_space(4))) Params& CPR;
enum { I_XP = 0, I_XS, I_CK, I_CV, I_SG, I_SR, I_C, I_CCTX, I_WMOD, I_BMOD, I_NMIX, I_WIN, I_QN, I_KN, I_GAUP, I_GABIAS, I_GNORM, I_RMU, I_RW0, I_RWUP, I_RA0, I_RAUP, I_RGUP,
       I_RXI, I_RALPHA, I_RBONUS, I_RLNW, I_RLNB, I_WBRA, I_WBRG, I_WBRR, I_WOUT, I_NFFN, I_FUP, I_FCW, I_FCB, I_FDOWN };

__device__ __forceinline__ float wave_sum(float v) {
#pragma unroll
    for (int o = 32; o > 0; o >>= 1) v += __shfl_xor(v, o);
    return v;
}
__device__ __forceinline__ float frcp(float x) { return __builtin_amdgcn_rcpf(x); }
__device__ __forceinline__ float sigmoidf_(float x) { return frcp(1.0f + __expf(-x)); }
__device__ __forceinline__ float siluf_(float x) { return x * frcp(1.0f + __expf(-x)); }
__device__ __forceinline__ bf16_t f2bf(float f) { unsigned u = __float_as_uint(f); u += 0x7FFFu + ((u >> 16) & 1u); return (bf16_t)(u >> 16); }
__device__ __forceinline__ float bf2f(bf16_t b) { return __uint_as_float(((unsigned)b) << 16); }
__device__ __forceinline__ int kperm(int key, int d) { return ((((key >> 4) * 4 + (d >> 5)) * 4 + ((d & 31) >> 3)) * 16 + (key & 15)) * 8 + (d & 7); }
__device__ __forceinline__ float dpp_sum16(float x) {
    int xi = __builtin_bit_cast(int, x);
    x += __builtin_bit_cast(float, __builtin_amdgcn_update_dpp(0, xi, 0xB1, 0xf, 0xf, true));
    xi = __builtin_bit_cast(int, x);
    x += __builtin_bit_cast(float, __builtin_amdgcn_update_dpp(0, xi, 0x4E, 0xf, 0xf, true));
    xi = __builtin_bit_cast(int, x);
    x += __builtin_bit_cast(float, __builtin_amdgcn_update_dpp(0, xi, 0x141, 0xf, 0xf, true));
    xi = __builtin_bit_cast(int, x);
    x += __builtin_bit_cast(float, __builtin_amdgcn_update_dpp(0, xi, 0x140, 0xf, 0xf, true));
    return x;
}
__device__ __forceinline__ int mod_index(int tok) { return tok < NCTX ? 0 : 1 + ((tok - NCTX) >> 10); }

__device__ __forceinline__ int win_map(int n) {
    if (n < 3616) return n;
    if (n < 3840) return -1;
    if (n < 5696) return 3616 + (n - 3840);
    if (n < 5888) return -1;
    return 5472 + (n - 5888);
}
__device__ __forceinline__ void convert_job(LAS float* tile, const float* __restrict__ src, bf16_t* __restrict__ dst, int K, int Nsrc, int Ndst, int mode, int wg, int nwg, int ldd = 0) {
    if (ldd == 0) ldd = K;
    const int tid = tid_l();
    const int tk = K / 64, tn = Ndst / 256, nt = tk * tn;
    for (int t = wg; t < nt; t += nwg) {
        const int k0 = (t % tk) * 64, n0 = (t / tk) * 256;
        {
            const int c4 = tid & 63, i0 = tid >> 6;
            const int n = n0 + c4 * 4; const int on = mode ? win_map(n) : n;
            f32x4 v[8];
#pragma unroll
            for (int r = 0; r < 8; ++r) { const int i = i0 + 8 * r; v[r] = (on >= 0) ? __builtin_nontemporal_load((const f32x4*)(src + (size_t)(k0 + i) * Nsrc + on)) : (f32x4){0.f, 0.f, 0.f, 0.f}; }
#pragma unroll
            for (int r = 0; r < 8; ++r) { LAS float* tp = tile + (i0 + 8 * r) * 257 + c4 * 4; tp[0] = v[r][0]; tp[1] = v[r][1]; tp[2] = v[r][2]; tp[3] = v[r][3]; }
        }
        __syncthreads();
        {
            const int kp = tid & 7;
#pragma unroll
            for (int ps = 0; ps < 4; ++ps) { const int nl = ps * 64 + (tid >> 3); const LAS float* tp = tile + (kp * 8) * 257 + nl;
                u32x4 w; w.x = cvt_pk_bf16(tp[0], tp[257]); w.y = cvt_pk_bf16(tp[2 * 257], tp[3 * 257]); w.z = cvt_pk_bf16(tp[4 * 257], tp[5 * 257]); w.w = cvt_pk_bf16(tp[6 * 257], tp[7 * 257]);
                *(u32x4*)(dst + (size_t)(n0 + nl) * ldd + k0 + kp * 8) = w; }
        }
        __syncthreads();
    }
}
__device__ __forceinline__ void convert_lr(CPR p, int l, bf16_t* dst, int gtid, int gthreads) {
    const float* wup = p.in[I_RWUP] + (size_t)l * 2 * 64 * 512;
    const float* aup = p.in[I_RAUP] + (size_t)l * 64 * 512;
    const float* gup = p.in[I_RGUP] + (size_t)l * 128 * 512;
    for (int idx = gtid; idx < 2048 * 384; idx += gthreads) {
        const int n = idx / 384, k = idx - n * 384; float v = 0.f;
        if (n < 512) { if (k < 64) v = wup[(size_t)k * 512 + n]; }
        else if (n < 1024) { if (k >= 64 && k < 128) v = wup[(size_t)(64 + (k - 64)) * 512 + (n - 512)]; }
        else if (n < 1536) { if (k >= 128 && k < 192) v = aup[(size_t)(k - 128) * 512 + (n - 1024)]; }
        else { if (k >= 192 && k < 320) v = gup[(size_t)(k - 192) * 512 + (n - 1536)]; }
        dst[idx] = f2bf(v);
    }
}

__device__ __forceinline__ void mod_phase(CPR p, LAS float* lds, int wg, int nwg) {
    const int tid = tid_l();
    LAS float* sc = lds;
    LAS float* red = lds + 5 * 2048;
    for (int i = tid; i < 5 * 2048; i += 512) { const int j = i >> 11, k = i & 2047; const float c = (j == 0) ? p.in[I_CCTX][k] : p.in[I_C][(j - 1) * 2048 + k]; sc[i] = siluf_(c); }
    __syncthreads();
    float* mod = (float*)(p.ws + WS_MOD);
    for (int item = wg; item < 256; item += nwg) {
        const int l = item >> 7, col0 = (item & 127) * 96;
        const float* W = p.in[I_WMOD] + (size_t)l * 2048 * 12288;
        const int c4 = tid % 24, kg = tid / 24;
        if (kg < 16) {
            f32x4 acc[5];
#pragma unroll
            for (int j = 0; j < 5; ++j) acc[j] = (f32x4){0.f, 0.f, 0.f, 0.f};
            const float* wp = W + (size_t)(kg * 128) * 12288 + col0 + c4 * 4;
#pragma unroll 8
            for (int k = 0; k < 128; ++k) { const f32x4 w = __builtin_nontemporal_load((const f32x4*)(wp + (size_t)k * 12288));
#pragma unroll
                for (int j = 0; j < 5; ++j) acc[j] += w * sc[j * 2048 + kg * 128 + k]; }
#pragma unroll
            for (int j = 0; j < 5; ++j)
#pragma unroll
                for (int e = 0; e < 4; ++e) red[(kg * 5 + j) * 96 + c4 * 4 + e] = acc[j][e];
        }
        __syncthreads();
        if (tid < 480) { const int j = tid / 96, c = tid % 96; float s = p.in[I_BMOD][l * 12288 + col0 + c];
            for (int g = 0; g < 16; ++g) s += red[(g * 5 + j) * 96 + c];
            mod[((size_t)l * 5 + j) * 12288 + col0 + c] = s; }
        __syncthreads();
    }
}

__device__ __forceinline__ void norm_phase(CPR p, int l, bool first, const float* gamma, int sh_idx, int sc_idx, int gwave, int nwave) {
    const int lane = tid_l() & 63;
    float* x = p.out + O_X; bf16_t* H = (bf16_t*)(p.ws + WS_H);
    const float* mod = (const float*)(p.ws + WS_MOD) + (size_t)l * 5 * 12288;
    for (int tok = gwave; tok < NTOK; tok += nwave) {
        const float* src = first ? (tok < NCTX ? p.in[I_XP] + (size_t)tok * DM : p.in[I_XS] + (size_t)(tok - NCTX) * DM) : x + (size_t)tok * DM;
        const float* mj = mod + (size_t)mod_index(tok) * 12288;
        f32x4 v[8]; float ss = 0.f;
#pragma unroll
        for (int i = 0; i < 8; ++i) { v[i] = *(const f32x4*)(src + lane * 4 + i * 256); ss += v[i][0] * v[i][0] + v[i][1] * v[i][1] + v[i][2] * v[i][2] + v[i][3] * v[i][3]; }
        ss = wave_sum(ss);
        const float rs = rsqrtf(ss * (1.0f / 2048.0f) + 1e-6f);
#pragma unroll
        for (int i = 0; i < 8; ++i) { const int c = lane * 4 + i * 256;
            const f32x4 g = *(const f32x4*)(gamma + c), scv = *(const f32x4*)(mj + sc_idx * 2048 + c), shv = *(const f32x4*)(mj + sh_idx * 2048 + c);
            const f32x4 h = (v[i] * rs * g) * (scv + 1.0f) + shv;
            u32x2 w; w.x = cvt_pk_bf16(h[0], h[1]); w.y = cvt_pk_bf16(h[2], h[3]);
            *(u32x2*)(H + (size_t)tok * DM + c) = w;
 }
    }
}

template <class F> __device__ __forceinline__ void epi_loop(const f32x4 (&acc)[2][2][4][2], const pg8::Unit& u, int wr, int wc, int fr, int fq, F&& f) {
    asm volatile("" : "+v"(fr), "+v"(fq)); asm volatile("" : "+s"(wr), "+s"(wc));
#pragma unroll
    for (int ai = 0; ai < 2; ++ai)
#pragma unroll
        for (int m = 0; m < 4; ++m) { const int row = u.pm * 256 + ai * 128 + wr * 64 + m * 16 + fr;
#pragma unroll
            for (int bj = 0; bj < 2; ++bj)
#pragma unroll
                for (int n = 0; n < 2; ++n) { const int col = u.pn * 256 + bj * 128 + wc * 32 + n * 16 + 4 * fq; f(row, col, acc[ai][bj][m][n]); } }
}
#define EPI_BEGIN epi_loop(acc, u, wr, wc, fr, fq, [&](const int row, const int col, const f32x4 a) {
#define EPI_END });

struct EpiIn {
    static constexpr bool PERM = true, AFTER_DRAIN = false, HAS_MID = false;
    float* P; bf16_t* G;
    __device__ __forceinline__ void operator()(const f32x4 (&acc)[2][2][4][2], const pg8::Unit& u, int wr, int wc, int fr, int fq) const {
        asm volatile("" : "+v"(fr), "+v"(fq)); asm volatile("" : "+s"(wr), "+s"(wc));
#pragma unroll
        for (int ai = 0; ai < 2; ++ai)
#pragma unroll
            for (int m = 0; m < 4; ++m) { const int row = u.pm * 256 + ai * 128 + wr * 64 + m * 16 + fr;
#pragma unroll
                for (int bj = 0; bj < 2; ++bj) { const int col = u.pn * 256 + bj * 128 + wc * 32 + 8 * fq; const f32x4 v0 = acc[ai][bj][m][0], v1 = acc[ai][bj][m][1];
                    if (u.pn < 23) { float* pp = P + (size_t)row * PW + col; *(f32x4*)pp = v0; *(f32x4*)(pp + 4) = v1; }
                    else { u32x4 w; w.x = cvt_pk_bf16(v0[0], v0[1]); w.y = cvt_pk_bf16(v0[2], v0[3]); w.z = cvt_pk_bf16(v1[0], v1[1]); w.w = cvt_pk_bf16(v1[2], v1[3]);
                           *(u32x4*)(G + (size_t)row * GW + (col - 5888)) = w; } } }
    }
};
struct EpiUp {
    static constexpr bool PERM = true, AFTER_DRAIN = false, HAS_MID = false;
    bf16_t* U;
    __device__ __forceinline__ void operator()(const f32x4 (&acc)[2][2][4][2], const pg8::Unit& u, int wr, int wc, int fr, int fq) const {
        asm volatile("" : "+v"(fr), "+v"(fq)); asm volatile("" : "+s"(wr), "+s"(wc));
#pragma unroll
        for (int ai = 0; ai < 2; ++ai)
#pragma unroll
            for (int m = 0; m < 4; ++m) { const int row = u.pm * 256 + ai * 128 + wr * 64 + m * 16 + fr;
#pragma unroll
                for (int bj = 0; bj < 2; ++bj) { const int col = u.pn * 256 + bj * 128 + wc * 32 + 8 * fq; const f32x4 v0 = acc[ai][bj][m][0], v1 = acc[ai][bj][m][1];
                    u32x4 w; w.x = cvt_pk_bf16(v0[0], v0[1]); w.y = cvt_pk_bf16(v0[2], v0[3]); w.z = cvt_pk_bf16(v1[0], v1[1]); w.w = cvt_pk_bf16(v1[2], v1[3]);
                    *(u32x4*)(U + (size_t)row * FU + col) = w; } }
    }
};
struct EpiRes {
    static constexpr bool PERM = false, AFTER_DRAIN = false, HAS_MID = false;
    float* x; const float* gate;
    const float* xin0; const float* xin1;
    __device__ __forceinline__ void operator()(const f32x4 (&acc)[2][2][4][2], const pg8::Unit& u, int wr, int wc, int fr, int fq) const {
        EPI_BEGIN  const f32x4 g = *(const f32x4*)(gate + (size_t)mod_index(row) * 12288 + col); float* xp = x + (size_t)row * DM + col;
            const float* src = xin0 ? (row < NCTX ? xin0 + (size_t)row * DM + col : xin1 + (size_t)(row - NCTX) * DM + col) : xp;
            const f32x4 xv = *(const f32x4*)src; *(f32x4*)xp = xv + g * a;  EPI_END
    }
};
struct EpiBr {
    static constexpr bool PERM = false, AFTER_DRAIN = false, HAS_MID = false;
    float* Mb; bf16_t* merged; const bf16_t* G; int mode;
    __device__ __forceinline__ void operator()(const f32x4 (&acc)[2][2][4][2], const pg8::Unit& u, int wr, int wc, int fr, int fq) const {
        EPI_BEGIN  const u32x2 gw = *(const u32x2*)(G + (size_t)row * GW + mode * 2048 + col);
            f32x4 g; g[0] = sigmoidf_(__uint_as_float(gw.x << 16)); g[1] = sigmoidf_(__uint_as_float(gw.x & 0xffff0000u)); g[2] = sigmoidf_(__uint_as_float(gw.y << 16)); g[3] = sigmoidf_(__uint_as_float(gw.y & 0xffff0000u));
            float* mp = Mb + (size_t)row * DM + col; f32x4 r = g * a;
            if (mode > 0) r += *(const f32x4*)mp;
            if (mode < 2) *(f32x4*)mp = r;
            else { u32x2 w; w.x = cvt_pk_bf16(r[0], r[1]); w.y = cvt_pk_bf16(r[2], r[3]); *(u32x2*)(merged + (size_t)row * DM + col) = w; }  EPI_END
    }
};
struct EpiBrF {
    static constexpr bool PERM = false, AFTER_DRAIN = false, HAS_MID = true;
    bf16_t* merged; const bf16_t* G;
    __device__ __forceinline__ bool mid_at(int t) const { return t == 16 || t == 24; }
    static __device__ __forceinline__ float em(unsigned bits) { const float x = fminf(fmaxf(__uint_as_float(bits), -30.0f), 30.0f); return 1.0f + __expf(-x); }
    __device__ __forceinline__ void mid(f32x4 (&acc)[2][2][4][2], const pg8::Unit& u, int t, int wr, int wc, int fr, int fq) const {
        asm volatile("" : "+v"(fr), "+v"(fq)); asm volatile("" : "+s"(wr), "+s"(wc));
        const int gi = (t == 16) ? 0 : 1;
#pragma unroll
        for (int ai = 0; ai < 2; ++ai)
#pragma unroll
            for (int m = 0; m < 4; ++m) { const int row = u.pm * 256 + ai * 128 + wr * 64 + m * 16 + fr;
#pragma unroll
                for (int bj = 0; bj < 2; ++bj)
#pragma unroll
                    for (int n = 0; n < 2; ++n) { const int col = u.pn * 256 + bj * 128 + wc * 32 + n * 16 + 4 * fq;
                        const bf16_t* gp = G + (size_t)row * GW + gi * 2048 + col;
                        const u32x2 xa = *(const u32x2*)gp, xb = *(const u32x2*)(gp + 2048);
                        f32x4 r;
                        r[0] = em(xb.x << 16) * frcp(em(xa.x << 16)); r[1] = em(xb.x & 0xffff0000u) * frcp(em(xa.x & 0xffff0000u));
                        r[2] = em(xb.y << 16) * frcp(em(xa.y << 16)); r[3] = em(xb.y & 0xffff0000u) * frcp(em(xa.y & 0xffff0000u));
                        acc[ai][bj][m][n] *= r; } }
    }
    __device__ __forceinline__ void operator()(const f32x4 (&acc)[2][2][4][2], const pg8::Unit& u, int wr, int wc, int fr, int fq) const {
        EPI_BEGIN const u32x2 gw = *(const u32x2*)(G + (size_t)row * GW + 2 * 2048 + col);
            f32x4 r; r[0] = a[0] * frcp(em(gw.x << 16)); r[1] = a[1] * frcp(em(gw.x & 0xffff0000u)); r[2] = a[2] * frcp(em(gw.y << 16)); r[3] = a[3] * frcp(em(gw.y & 0xffff0000u));
            u32x2 w; w.x = cvt_pk_bf16(r[0], r[1]); w.y = cvt_pk_bf16(r[2], r[3]); *(u32x2*)(merged + (size_t)row * DM + col) = w; EPI_END
    }
};
struct EpiLr {
    static constexpr bool PERM = false, AFTER_DRAIN = false, HAS_MID = false;
    float* scan; float* gout; const float* w0; const float* a0; const float* alpha;
    __device__ __forceinline__ void operator()(const f32x4 (&acc)[2][2][4][2], const pg8::Unit& u, int wr, int wc, int fr, int fq) const {
        const int sect = u.pn >> 1;
        if (sect < 2) {
            EPI_BEGIN const int c = col & 511; float* sb = scan + ((size_t)row * 8 + (c >> 6)) * SB_STRIDE + (c & 63);
                const f32x4 b = *(const f32x4*)(w0 + sect * 512 + c); f32x4 w;
#pragma unroll
                for (int e = 0; e < 4; ++e) w[e] = __expf(-0.606531f * sigmoidf_(b[e] + a[e]));
                *(f32x4*)(sb + 320 + sect * 64) = w; EPI_END
        } else if (sect == 2) {
            EPI_BEGIN const int c = col & 511; float* sb = scan + ((size_t)row * 8 + (c >> 6)) * SB_STRIDE + (c & 63);
                const f32x4 b = *(const f32x4*)(a0 + c), al = *(const f32x4*)(alpha + c); const f32x4 rk = *(const f32x4*)(sb + 64), kap = *(const f32x4*)(sb + 192); f32x4 kk, ka;
#pragma unroll
                for (int e = 0; e < 4; ++e) { const float av = sigmoidf_(b[e] + a[e]); kk[e] = rk[e] * (1.0f + (av - 1.0f) * al[e]); ka[e] = kap[e] * av; }
                *(f32x4*)(sb + 64) = kk; *(f32x4*)(sb + 256) = ka; EPI_END
        } else {
            EPI_BEGIN const int c = col & 511; *(f32x4*)(gout + (size_t)row * 512 + c) = a; EPI_END
        }
    }
};

template <class Epi> __device__ __forceinline__ void run_gemm(LAS unsigned char* lds, const bf16_t* A, const bf16_t* Bt, int N, int K, const Epi& E) {
    asm volatile("" : "+s"(N)); asm volatile("" : "+s"(K));
    pg8::Gemm g; g.A = A; g.Bt = Bt; g.M = NTOK; g.N = N; g.K = K;
    pg8::StaticOrder S; S.init(NTOK, N, (int)gridDim.x, (int)blockIdx.x);
    pg8::gemm_phase<Epi, pg8::StaticOrder, false>(lds, g, S, E, nullptr);
    __syncthreads();
}

__device__ __forceinline__ void prep_phase(CPR p, int l, int gwave, int nwave) {
    const int lane = tid_l() & 63;
    const float* P = (const float*)(p.ws + WS_P);
    bf16_t* Qb = (bf16_t*)(p.ws + WS_QB); bf16_t* Kc = (bf16_t*)(p.ws + WS_KC); bf16_t* Vtc = (bf16_t*)(p.ws + WS_VTC); bf16_t* Kl = (bf16_t*)(p.ws + WS_KL); bf16_t* Vtl = (bf16_t*)(p.ws + WS_VTL);
    float* scan = (float*)(p.ws + WS_SCAN); bf16_t* Alr = (bf16_t*)(p.ws + WS_ALR);
    for (int it = gwave; it < 2048; it += nwave) {
        const int t = it & 255, h = (it >> 8) & 1, b = it >> 9;
        const size_t src = ((((size_t)b * 2 + l) * 2 + h) * 256 + t) * 128;
        const f32x2 kv = *(const f32x2*)(p.in[I_CK] + src + lane * 2), vv = *(const f32x2*)(p.in[I_CV] + src + lane * 2);
        *(unsigned*)(Kl + ((size_t)b * 2 + h) * 1280 * 128 + kperm(t, lane * 2)) = cvt_pk_bf16(kv[0], kv[1]);
        { const int kk = t & 31, pp = ((kk & 15) >> 2) * 8 + (kk >> 4) * 4 + (kk & 3); bf16_t* vt = Vtl + ((((size_t)b * 2 + h) * 40 + (t >> 5)) * 128) * 32 + pp;
          vt[(size_t)(lane * 2) * 32] = f2bf(vv[0]); vt[(size_t)(lane * 2 + 1) * 32] = f2bf(vv[1]); }
    }
    const float* qn = p.in[I_QN] + l * 128; const float* kn = p.in[I_KN] + l * 128;
    const float* mu = p.in[I_RMU] + l * 1856; const float* xi = p.in[I_RXI] + l * 512;
    const int hw = lane >> 5, j = lane & 31;
    const bool lowhalf = (j & 15) < 8;
    f32x4 inv4;
#pragma unroll
    for (int e = 0; e < 4; ++e) inv4[e] = exp2f(-(float)(2 * ((4 * j + e) & 31)) * (13.287712379549449f / 64.0f));
    const f32x4 qg = *(const f32x4*)(qn + 4 * j), kg = *(const f32x4*)(kn + 4 * j);
    for (int tok = gwave; tok < NTOK; tok += nwave) {
        const bool lat = tok >= NCTX;
        const int b = lat ? (tok - NCTX) >> 10 : tok >> 8, t = lat ? (tok - NCTX) & 1023 : tok & 255, T = lat ? 1024 : 256;
        const float* pr = P + (size_t)tok * PW;
        f32x4 cs = (f32x4){1.f, 1.f, 1.f, 1.f}, sn = (f32x4){0.f, 0.f, 0.f, 0.f};
        if (lat) { const float pos = (float)((j >> 4) == 0 ? (t >> 6) : (t & 63));
#pragma unroll
            for (int e = 0; e < 4; ++e) { const float ang = pos * inv4[e]; sn[e] = __sinf(ang); cs[e] = __cosf(ang); } }
        f32x4 xin[6];
#pragma unroll
        for (int s2 = 0; s2 < 6; ++s2) { const int slot = 2 * s2 + hw; const int col = slot < 8 ? P_AQ + slot * 128 : (slot < 10 ? P_AK + (slot - 8) * 128 : P_AV + (slot - 10) * 128); xin[s2] = __builtin_nontemporal_load((const f32x4*)(pr + col + 4 * j)); }
#pragma unroll
        for (int s2 = 0; s2 < 6; ++s2) {
            const int slot = 2 * s2 + hw; f32x4 x = xin[s2];
            if (s2 < 5) {
                float ss = (x[0] * x[0] + x[1] * x[1]) + (x[2] * x[2] + x[3] * x[3]);
                ss = dpp_sum16(ss); ss += __shfl_xor(ss, 16);
                const float rs = rsqrtf(ss * (1.0f / 128.0f) + 1e-6f);
                x = x * rs * (s2 < 4 ? qg : kg);
                if (lat) { f32x4 pt;
#pragma unroll
                    for (int e = 0; e < 4; ++e) pt[e] = __shfl_xor(x[e], 8);
                    x = lowhalf ? x * cs - pt * sn : x * cs + pt * sn; }
            }
            u32x2 xb; xb.x = cvt_pk_bf16(x[0], x[1]); xb.y = cvt_pk_bf16(x[2], x[3]);
            if (s2 < 4) { *(u32x2*)(Qb + (size_t)tok * 1024 + slot * 128 + 4 * j) = xb; }
            else if (s2 == 4) { const int h = hw;
                if (!lat) { *(f32x4*)(p.out + O_CK + ((((size_t)b * 2 + l) * 2 + h) * 256 + t) * 128 + 4 * j) = x;
                            *(u32x2*)(Kc + ((size_t)b * 2 + h) * 256 * 128 + kperm(t, 4 * j)) = xb; }
                else { *(u32x2*)(Kl + ((size_t)b * 2 + h) * 1280 * 128 + kperm(256 + t, 4 * j)) = xb; } }
            else { const int h = hw;
                if (!lat) { *(f32x4*)(p.out + O_CV + ((((size_t)b * 2 + l) * 2 + h) * 256 + t) * 128 + 4 * j) = x;
                            const int kk = t & 31, pp = ((kk & 15) >> 2) * 8 + (kk >> 4) * 4 + (kk & 3);
                            bf16_t* vt = Vtc + ((((size_t)b * 2 + h) * 8 + (t >> 5)) * 128 + 4 * j) * 32 + pp;
                            vt[0] = (bf16_t)(xb.x & 0xffffu); vt[32] = (bf16_t)(xb.x >> 16); vt[64] = (bf16_t)(xb.y & 0xffffu); vt[96] = (bf16_t)(xb.y >> 16); }
                else { const int key = 256 + t, kk = key & 31, pp = ((kk & 15) >> 2) * 8 + (kk >> 4) * 4 + (kk & 3);
                       bf16_t* vt = Vtl + ((((size_t)b * 2 + h) * 40 + (key >> 5)) * 128 + 4 * j) * 32 + pp;
                       vt[0] = (bf16_t)(xb.x & 0xffffu); vt[32] = (bf16_t)(xb.x >> 16); vt[64] = (bf16_t)(xb.y & 0xffffu); vt[96] = (bf16_t)(xb.y >> 16); } }
        }
        const bool hp = t > 0, hn = t < T - 1;
        f32x4 mx[8];
        {
            f32x4 xc[8], xp[8], xn[8];
            const f32x4 z4 = (f32x4){0.f, 0.f, 0.f, 0.f};
#pragma unroll
            for (int it = 0; it < 8; ++it) { const int f = it * 64 + lane; const bool ok = f < 464; const float* q = pr + P_RW + 4 * f;
                xc[it] = ok ? *(const f32x4*)q : z4; xp[it] = (ok && hp) ? *(const f32x4*)(q - PW) : z4; xn[it] = (ok && hn) ? *(const f32x4*)(q + PW) : z4; }
#pragma unroll
            for (int it = 0; it < 8; ++it) { const int f = it * 64 + lane; const f32x4 m4 = (f < 464) ? *(const f32x4*)(mu + 4 * f) : z4; mx[it] = xc[it] + ((xp[it] + xn[it]) * 0.5f - xc[it]) * m4; }
        }
#pragma unroll
        for (int it = 0; it < 8; ++it) { const int f = it * 64 + lane; const int c = 4 * f;
            if (it < 2) { *(f32x4*)(scan + ((size_t)tok * 8 + (c >> 6)) * SB_STRIDE + (c & 63)) = mx[it]; }
            else if (it < 4) { const int cc = c - 512; float* sb = scan + ((size_t)tok * 8 + (cc >> 6)) * SB_STRIDE + (cc & 63);
                *(f32x4*)(sb + 64) = mx[it];
                const f32x4 kx = mx[it] * *(const f32x4*)(xi + cc);
                const float ss = dpp_sum16((kx[0] * kx[0] + kx[1] * kx[1]) + (kx[2] * kx[2] + kx[3] * kx[3]));
                *(f32x4*)(sb + 192) = kx * rsqrtf(ss + 1e-6f); }
            else if (it < 6) { const int cc = c - 1024; *(f32x4*)(scan + ((size_t)tok * 8 + (cc >> 6)) * SB_STRIDE + 128 + (cc & 63)) = mx[it]; }
            else if (f < 464) { const int cc = c - 1536;
                f32x4 v;
#pragma unroll
                for (int e = 0; e < 4; ++e) v[e] = cc < 128 ? (1.0f - 2.0f * frcp(1.0f + __expf(2.0f * mx[it][e]))) : (cc < 192 ? mx[it][e] : sigmoidf_(mx[it][e]));
                u32x2 w; w.x = cvt_pk_bf16(v[0], v[1]); w.y = cvt_pk_bf16(v[2], v[3]); *(u32x2*)(Alr + (size_t)tok * 384 + cc) = w; }
        }
        if (lane < 16) *(u32x2*)(Alr + (size_t)tok * 384 + 320 + lane * 4) = (u32x2){0u, 0u};
    }
}

template <int QT> __device__ __forceinline__ void attn_item(const bf16_t* __restrict__ Q, const bf16_t* __restrict__ K, const bf16_t* __restrict__ Vt, int Tk, bf16_t* __restrict__ O, int lane) {
    const int fr = lane & 15, fq = lane >> 4;
    bf16x8 qf[QT][4];
#pragma unroll
    for (int t = 0; t < QT; ++t)
#pragma unroll
        for (int kc = 0; kc < 4; ++kc) qf[t][kc] = *(const bf16x8*)(Q + (size_t)(t * 16 + fr) * 1024 + kc * 32 + fq * 8);
    f32x4 o[QT][8]; float mrun[QT], lrun[QT];
#pragma unroll
    for (int t = 0; t < QT; ++t) { mrun[t] = -1e30f; lrun[t] = 0.f;
#pragma unroll
        for (int dt = 0; dt < 8; ++dt) o[t][dt] = (f32x4){0.f, 0.f, 0.f, 0.f}; }
    const float scl = 0.08838834764831845f * 1.4426950408889634f;
    bf16x8 kf[2][4];
#pragma unroll
    for (int kt = 0; kt < 2; ++kt)
#pragma unroll
        for (int kc = 0; kc < 4; ++kc) kf[kt][kc] = *(const bf16x8*)(K + ((size_t)(kt * 4 + kc) * 64 + lane) * 8);
    for (int kb = 0; kb < Tk; kb += 32) {
        bf16x8 vfr[8];
#pragma unroll
        for (int dt = 0; dt < 8; ++dt) vfr[dt] = *(const bf16x8*)(Vt + ((size_t)(kb >> 5) * 128 + dt * 16 + fr) * 32 + fq * 8);
        f32x4 s0[QT], s1[QT];
#pragma unroll
        for (int t = 0; t < QT; ++t) { s0[t] = (f32x4){0.f, 0.f, 0.f, 0.f}; s1[t] = (f32x4){0.f, 0.f, 0.f, 0.f};
#pragma unroll
            for (int kc = 0; kc < 4; ++kc) { s0[t] = __builtin_amdgcn_mfma_f32_16x16x32_bf16(kf[0][kc], qf[t][kc], s0[t], 0, 0, 0); s1[t] = __builtin_amdgcn_mfma_f32_16x16x32_bf16(kf[1][kc], qf[t][kc], s1[t], 0, 0, 0); } }
        { const int kbn = (kb + 32 < Tk) ? kb + 32 : kb;
#pragma unroll
          for (int kt = 0; kt < 2; ++kt)
#pragma unroll
            for (int kc = 0; kc < 4; ++kc) kf[kt][kc] = *(const bf16x8*)(K + ((size_t)(((kbn >> 4) + kt) * 4 + kc) * 64 + lane) * 8); }
        bf16x8 pb[QT];
#pragma unroll
        for (int t = 0; t < QT; ++t) {
            f32x4 a0 = s0[t] * scl, a1 = s1[t] * scl;
            float mx = fmaxf(fmaxf(fmaxf(a0[0], a0[1]), fmaxf(a0[2], a0[3])), fmaxf(fmaxf(a1[0], a1[1]), fmaxf(a1[2], a1[3])));
            mx = fmaxf(mx, __shfl_xor(mx, 16)); mx = fmaxf(mx, __shfl_xor(mx, 32));
            const float mnew = (mx > mrun[t] + 8.0f) ? mx : mrun[t];
            if (__builtin_amdgcn_ballot_w64(mnew != mrun[t]) != 0ull) {
                const float alpha = __builtin_amdgcn_exp2f(fmaxf(mrun[t] - mnew, -126.0f)); lrun[t] *= alpha;
#pragma unroll
                for (int dt = 0; dt < 8; ++dt) o[t][dt] *= alpha;
                mrun[t] = mnew;
            }
            float ps = 0.f;
#pragma unroll
            for (int e = 0; e < 4; ++e) { a0[e] = __builtin_amdgcn_exp2f(a0[e] - mnew); a1[e] = __builtin_amdgcn_exp2f(a1[e] - mnew); ps += a0[e] + a1[e]; }
            lrun[t] += ps;
            u32x4 w; w.x = cvt_pk_bf16(a0[0], a0[1]); w.y = cvt_pk_bf16(a0[2], a0[3]); w.z = cvt_pk_bf16(a1[0], a1[1]); w.w = cvt_pk_bf16(a1[2], a1[3]);
            pb[t] = __builtin_bit_cast(bf16x8, w);
        }
#pragma unroll
        for (int dt = 0; dt < 8; ++dt) {
#pragma unroll
            for (int t = 0; t < QT; ++t) o[t][dt] = __builtin_amdgcn_mfma_f32_16x16x32_bf16(vfr[dt], pb[t], o[t][dt], 0, 0, 0);
        }
    }
#pragma unroll
    for (int t = 0; t < QT; ++t) {
        float l = lrun[t]; l += __shfl_xor(l, 16); l += __shfl_xor(l, 32);
        const float li = frcp(l);
#pragma unroll
        for (int dt = 0; dt < 8; ++dt) { const f32x4 v = o[t][dt] * li; u32x2 w; w.x = cvt_pk_bf16(v[0], v[1]); w.y = cvt_pk_bf16(v[2], v[3]);
            *(u32x2*)(O + (size_t)(t * 16 + fr) * 2048 + dt * 16 + fq * 4) = w; }
    }
}
__device__ __forceinline__ void attn_phase(CPR p) {
    const int wid = tid_l() >> 6, lane = tid_l() & 63;
    const bf16_t* Qb = (const bf16_t*)(p.ws + WS_QB); bf16_t* Oa = (bf16_t*)(p.ws + WS_OATT);
    const bf16_t* Kc = (const bf16_t*)(p.ws + WS_KC); const bf16_t* Vtc = (const bf16_t*)(p.ws + WS_VTC); const bf16_t* Kl = (const bf16_t*)(p.ws + WS_KL); const bf16_t* Vtl = (const bf16_t*)(p.ws + WS_VTL);
    for (int i = blockIdx.x * 4 + (wid & 3); i < 1024; i += gridDim.x * 4) {
        if (wid < 4) {
            const int qt = i & 31, hq = (i >> 5) & 7, b = i >> 8, hk = hq >> 2;
            const size_t tok0 = NCTX + (size_t)b * 1024 + qt * 32;
            attn_item<2>(Qb + tok0 * 1024 + hq * 128, Kl + ((size_t)b * 2 + hk) * 1280 * 128, Vtl + ((size_t)b * 2 + hk) * 128 * 1280, 1280, Oa + tok0 * 2048 + hq * 128, lane);
        } else {
            const int qt = i & 7, hq = (i >> 3) & 7, b = i >> 6, hk = hq >> 2;
            const size_t tok0 = (size_t)b * 256 + qt * 32;
            attn_item<2>(Qb + tok0 * 1024 + hq * 128, Kc + ((size_t)b * 2 + hk) * 256 * 128, Vtc + ((size_t)b * 2 + hk) * 128 * 256, 256, Oa + tok0 * 2048 + hq * 128, lane);
        }
    }
}

constexpr int GL_GAD = 0, GL_TOT = 4096, GL_QE = 6144, GL_KE = 23552, GL_KLT = 40960, GL_VT = 59392, GL_OSUM = 77824;
__device__ __forceinline__ float log_sigmoidf_(float z) { return fminf(z, 0.f) - __logf(1.0f + __expf(-fabsf(z))); }
__device__ __forceinline__ f32x4 gla_stage(LAS unsigned char* lds, CPR p, int l, int h, int cg, int dir) {
    const int tid = tid_l(), dq = tid & 31, rg = tid >> 5;
    const float* P = (const float*)(p.ws + WS_P);
    LAS float* gadL = (LAS float*)(lds + GL_GAD); LAS float* tot = (LAS float*)(lds + GL_OSUM);
    LAS bf16_t* qe = (LAS bf16_t*)(lds + GL_QE); LAS bf16_t* ke = (LAS bf16_t*)(lds + GL_KE); LAS bf16_t* klT = (LAS bf16_t*)(lds + GL_KLT); LAS bf16_t* vT = (LAS bf16_t*)(lds + GL_VT);
    const int tbase = cg * 64;
    { const int idx = tid * 2, i = idx >> 4, r = idx & 15; const int tok = dir ? tbase + 63 - i : tbase + i;
      const f32x2 g = *(const f32x2*)(P + (size_t)tok * PW + P_GAD + dir * 16 + r); gadL[idx] = g[0]; gadL[idx + 1] = g[1]; }
    const float* aup = p.in[I_GAUP] + ((size_t)l * 2 + dir) * 16 * 512 + h * 128 + 4 * dq;
    f32x4 au[16];
#pragma unroll
    for (int r = 0; r < 16; ++r) au[r] = *(const f32x4*)(aup + r * 512);
    const f32x4 bias = *(const f32x4*)(p.in[I_GABIAS] + ((size_t)l * 2 + dir) * 512 + h * 128 + 4 * dq);
    f32x4 q4[4], k4[4], v4[4];
#pragma unroll
    for (int k = 0; k < 4; ++k) { const int i = rg * 4 + k; const int tok = dir ? tbase + 63 - i : tbase + i; const float* pr = P + (size_t)tok * PW + h * 128 + 4 * dq;
        q4[k] = __builtin_nontemporal_load((const f32x4*)(pr + P_GQ)); k4[k] = __builtin_nontemporal_load((const f32x4*)(pr + P_GK)); v4[k] = __builtin_nontemporal_load((const f32x4*)(pr + P_GV)); }
    __syncthreads();
    f32x4 cl[4]; f32x4 c = (f32x4){0.f, 0.f, 0.f, 0.f};
#pragma unroll
    for (int k = 0; k < 4; ++k) { const int i = rg * 4 + k; f32x4 z = bias;
#pragma unroll
        for (int r = 0; r < 16; ++r) z += au[r] * gadL[i * 16 + r];
#pragma unroll
        for (int e = 0; e < 4; ++e) c[e] += log_sigmoidf_(z[e]) * (1.0f / 16.0f);
        cl[k] = c; }
    *(LAS f32x4*)(tot + rg * 128 + 4 * dq) = c;
    __syncthreads();
    f32x4 off = (f32x4){0.f, 0.f, 0.f, 0.f}, clast = (f32x4){0.f, 0.f, 0.f, 0.f};
#pragma unroll
    for (int g = 0; g < 16; ++g) { const f32x4 tv = *(const LAS f32x4*)(tot + g * 128 + 4 * dq); clast += tv; if (g < rg) off += tv; }
    f32x4 klr[4], vr[4];
#pragma unroll
    for (int k = 0; k < 4; ++k) { const int i = rg * 4 + k; const f32x4 cm = cl[k] + off; f32x4 qo, ko;
#pragma unroll
        for (int e = 0; e < 4; ++e) { const float E = __expf(cm[e]), iE = __expf(-cm[e]);
            qo[e] = q4[k][e] * 0.08838834764831845f * E; ko[e] = k4[k][e] * iE; klr[k][e] = k4[k][e] * __expf(clast[e] - cm[e]); }
        vr[k] = v4[k];
        u32x2 w; w.x = cvt_pk_bf16(qo[0], qo[1]); w.y = cvt_pk_bf16(qo[2], qo[3]); *(LAS u32x2*)(qe + i * 136 + 4 * dq) = w;
        w.x = cvt_pk_bf16(ko[0], ko[1]); w.y = cvt_pk_bf16(ko[2], ko[3]); *(LAS u32x2*)(ke + i * 136 + 4 * dq) = w; }
#pragma unroll
    for (int e = 0; e < 4; ++e) { u32x2 w;
        w.x = cvt_pk_bf16(klr[0][e], klr[1][e]); w.y = cvt_pk_bf16(klr[2][e], klr[3][e]); *(LAS u32x2*)(klT + (4 * dq + e) * 72 + rg * 4) = w;
        w.x = cvt_pk_bf16(vr[0][e], vr[1][e]); w.y = cvt_pk_bf16(vr[2][e], vr[3][e]); *(LAS u32x2*)(vT + (4 * dq + e) * 72 + rg * 4) = w; }
    __syncthreads();
    f32x4 dec;
#pragma unroll
    for (int e = 0; e < 4; ++e) dec[e] = __expf(clast[e]);
    return dec;
}
__device__ __forceinline__ void gla_g1(LAS unsigned char* lds, CPR p, int l) {
    const int tid = tid_l(), wid = tid >> 6, lane = tid & 63, fr = lane & 15, fq = lane >> 4;
    float* KVt = (float*)(p.ws + WS_KVT); float* DEC = (float*)(p.ws + WS_DEC);
    LAS bf16_t* klT = (LAS bf16_t*)(lds + GL_KLT); LAS bf16_t* vT = (LAS bf16_t*)(lds + GL_VT);
    for (int item = blockIdx.x; item < 1024; item += gridDim.x) {
        const int cg = item & 127, h = (item >> 7) & 3, dir = item >> 9;
        const f32x4 dec = gla_stage(lds, p, l, h, cg, dir);
        const size_t ib = ((size_t)dir * 4 + h) * 128 + cg;
        if (tid < 32) *(f32x4*)(DEC + ib * 128 + 4 * tid) = dec;
        { bf16_t* gst = (bf16_t*)(p.ws + WS_GST) + ib * 24576;
#pragma unroll
          for (int r = 0; r < 6; ++r) { const int c = tid + 512 * r; const int sect = c >> 10, cc = c & 1023;
              const LAS bf16_t* src = sect == 0 ? (LAS bf16_t*)(lds + GL_QE) + (cc >> 4) * 136 + (cc & 15) * 8 : (sect == 1 ? (LAS bf16_t*)(lds + GL_KE) + (cc >> 4) * 136 + (cc & 15) * 8 : (LAS bf16_t*)(lds + GL_VT) + (cc >> 3) * 72 + (cc & 7) * 8);
              *(u32x4*)(gst + (size_t)c * 8) = *(const LAS u32x4*)src; } }
        const int v0 = wid * 16;
        const bf16x8 a0 = *(const LAS bf16x8*)(vT + (v0 + fr) * 72 + fq * 8), a1 = *(const LAS bf16x8*)(vT + (v0 + fr) * 72 + 32 + fq * 8);
#pragma unroll
        for (int dt = 0; dt < 8; ++dt) {
            const bf16x8 b0 = *(const LAS bf16x8*)(klT + (dt * 16 + fr) * 72 + fq * 8), b1 = *(const LAS bf16x8*)(klT + (dt * 16 + fr) * 72 + 32 + fq * 8);
            f32x4 acc = (f32x4){0.f, 0.f, 0.f, 0.f};
            acc = __builtin_amdgcn_mfma_f32_16x16x32_bf16(b0, a0, acc, 0, 0, 0); acc = __builtin_amdgcn_mfma_f32_16x16x32_bf16(b1, a1, acc, 0, 0, 0);
            *(f32x4*)(KVt + (ib * 128 + v0 + fr) * 128 + dt * 16 + fq * 4) = acc;
        }
        __syncthreads();
    }
}
__device__ __forceinline__ void gla_g2(CPR p, int l, int gtid, int gthreads) {
    const float* KVt = (const float*)(p.ws + WS_KVT); const float* DEC = (const float*)(p.ws + WS_DEC); bf16_t* SSt = (bf16_t*)(p.ws + WS_SST);
    for (int idx = gtid; idx < 160 * 4096; idx += gthreads) {
        const int d4 = idx & 31, v = (idx >> 5) & 127, sc = idx >> 12;
        const int seq = sc % 20, dh = sc / 20, h = dh & 3, dir = dh >> 2;
        const bool lat = seq >= 16; const int N = lat ? 16 : 4, cg0 = lat ? 64 + (seq - 16) * 16 : seq * 4, b = lat ? seq - 16 : seq;
        f32x4 S = (f32x4){0.f, 0.f, 0.f, 0.f};
        if (lat) { const float* s0 = p.in[I_SG] + (((((size_t)b * 2 + l) * 2 + dir) * 4 + h) * 128 + d4 * 4) * 128 + v;
#pragma unroll
            for (int e = 0; e < 4; ++e) S[e] = s0[e * 128]; }
        for (int m = 0; m < N; ++m) {
            const int cg = dir ? cg0 + N - 1 - m : cg0 + m; const size_t ib = (size_t)dh * 128 + cg;
            u32x2 w; w.x = cvt_pk_bf16(S[0], S[1]); w.y = cvt_pk_bf16(S[2], S[3]);
            *(u32x2*)(SSt + (ib * 128 + v) * 128 + d4 * 4) = w;
            const f32x4 dec = *(const f32x4*)(DEC + ib * 128 + d4 * 4), kv = *(const f32x4*)(KVt + (ib * 128 + v) * 128 + d4 * 4);
            S = dec * S + kv;
        }
        if (!lat) { float* o = p.out + O_SG + (((((size_t)b * 2 + l) * 2 + dir) * 4 + h) * 128 + d4 * 4) * 128 + v;
#pragma unroll
            for (int e = 0; e < 4; ++e) o[e * 128] = S[e]; }
    }
}
__device__ __forceinline__ void gla_g3(LAS unsigned char* lds, CPR p, int l) {
    const int tid = tid_l(), wid = tid >> 6, lane = tid & 63, fr = lane & 15, fq = lane >> 4;
    const int it = wid & 3, vh = wid >> 2;
    const float* P = (const float*)(p.ws + WS_P); const bf16_t* SSt = (const bf16_t*)(p.ws + WS_SST); bf16_t* Og = (bf16_t*)(p.ws + WS_OATT) + 1024;
    LAS bf16_t* qe = (LAS bf16_t*)(lds + GL_QE); LAS bf16_t* ke = (LAS bf16_t*)(lds + GL_KE); LAS bf16_t* vT = (LAS bf16_t*)(lds + GL_VT); LAS float* osum = (LAS float*)(lds + GL_OSUM);
    const float* gn = p.in[I_GNORM] + l * 128;
    float one = 1.0f; asm volatile("" : "+v"(one));
    for (int item = blockIdx.x; item < 512; item += gridDim.x) {
        const int cg = item & 127, h = item >> 7;
#pragma unroll 1
        for (int dir = 0; dir < 2; ++dir) {
            bf16x8 sreg[4][4];
            { const bf16_t* ss0 = SSt + (((size_t)dir * 4 + h) * 128 + cg) * 16384;
#pragma unroll
              for (int vt = 0; vt < 4; ++vt)
#pragma unroll
                for (int kc = 0; kc < 4; ++kc) sreg[vt][kc] = *(const bf16x8*)(ss0 + (size_t)((vh * 4 + vt) * 16 + fr) * 128 + kc * 32 + fq * 8); }
            { const bf16_t* gst = (const bf16_t*)(p.ws + WS_GST) + (((size_t)dir * 4 + h) * 128 + cg) * 24576;
              u32x4 tmp[6];
#pragma unroll
              for (int r = 0; r < 6; ++r) tmp[r] = *(const u32x4*)(gst + (size_t)(tid + 512 * r) * 8);
#pragma unroll
              for (int r = 0; r < 6; ++r) { const int c = tid + 512 * r; const int sect = c >> 10, cc = c & 1023;
                  LAS bf16_t* dst = sect == 0 ? (LAS bf16_t*)(lds + GL_QE) + (cc >> 4) * 136 + (cc & 15) * 8 : (sect == 1 ? (LAS bf16_t*)(lds + GL_KE) + (cc >> 4) * 136 + (cc & 15) * 8 : (LAS bf16_t*)(lds + GL_VT) + (cc >> 3) * 72 + (cc & 7) * 8);
                  *(LAS u32x4*)dst = tmp[r]; }
              __syncthreads(); }
            bf16x8 qf[4];
#pragma unroll
            for (int kc = 0; kc < 4; ++kc) qf[kc] = *(const LAS bf16x8*)(qe + (it * 16 + fr) * 136 + kc * 32 + fq * 8);
            f32x4 o[4];
#pragma unroll
            for (int vt = 0; vt < 4; ++vt) o[vt] = (f32x4){0.f, 0.f, 0.f, 0.f};
            const bf16_t* ss = SSt + (((size_t)dir * 4 + h) * 128 + cg) * 16384;
#pragma unroll
            for (int vt = 0; vt < 4; ++vt) { const int v0 = (vh * 4 + vt) * 16;
#pragma unroll
                for (int kc = 0; kc < 4; ++kc) o[vt] = __builtin_amdgcn_mfma_f32_16x16x32_bf16(sreg[vt][kc], qf[kc], o[vt], 0, 0, 0); }
#pragma unroll
            for (int jp = 0; jp < 2; ++jp) {
                if (2 * jp <= it) {
                    f32x4 s[2];
#pragma unroll
                    for (int e = 0; e < 2; ++e) { const int jt = 2 * jp + e; s[e] = (f32x4){0.f, 0.f, 0.f, 0.f};
                        if (jt <= it) {
#pragma unroll
                            for (int kc = 0; kc < 4; ++kc) { const bf16x8 ka = *(const LAS bf16x8*)(ke + (jt * 16 + fr) * 136 + kc * 32 + fq * 8);
                                s[e] = __builtin_amdgcn_mfma_f32_16x16x32_bf16(ka, qf[kc], s[e], 0, 0, 0); }
                            if (jt == it) {
#pragma unroll
                                for (int j = 0; j < 4; ++j) if (fq * 4 + j > fr) s[e][j] = 0.f; }
                        } }
                    s[0] *= one; s[1] *= one;
                    u32x4 w; w.x = cvt_pk_bf16(s[0][0], s[0][1]); w.y = cvt_pk_bf16(s[0][2], s[0][3]); w.z = cvt_pk_bf16(s[1][0], s[1][1]); w.w = cvt_pk_bf16(s[1][2], s[1][3]);
                    const bf16x8 pb = __builtin_bit_cast(bf16x8, w);
#pragma unroll
                    for (int vt = 0; vt < 4; ++vt) { const int v0 = (vh * 4 + vt) * 16;
                        const LAS bf16_t* vp = vT + (v0 + fr) * 72 + jp * 32 + fq * 4;
                        const u32x2 va = *(const LAS u32x2*)vp, vb = *(const LAS u32x2*)(vp + 16);
                        u32x4 vw; vw.x = va.x; vw.y = va.y; vw.z = vb.x; vw.w = vb.y;
                        o[vt] = __builtin_amdgcn_mfma_f32_16x16x32_bf16(__builtin_bit_cast(bf16x8, vw), pb, o[vt], 0, 0, 0); }
                }
            }
            const int i = it * 16 + fr, tl = dir ? 63 - i : i;
#pragma unroll
            for (int vt = 0; vt < 4; ++vt) { LAS f32x4* op = (LAS f32x4*)(osum + tl * 132 + (vh * 4 + vt) * 16 + fq * 4);
                if (dir == 0) *op = o[vt]; else *op = *op + o[vt]; }
            __syncthreads();
        }
        { const int hw = lane >> 5, j = lane & 31; const f32x4 g4 = *(const f32x4*)(gn + 4 * j);
#pragma unroll
          for (int r = 0; r < 4; ++r) { const int tl = wid * 8 + r * 2 + hw, tok = cg * 64 + tl;
            const f32x4 x = *(const LAS f32x4*)(osum + tl * 132 + 4 * j);
            float ssq = (x[0] * x[0] + x[1] * x[1]) + (x[2] * x[2] + x[3] * x[3]);
            ssq = dpp_sum16(ssq); ssq += __shfl_xor(ssq, 16);
            const float rs = rsqrtf(ssq * (1.0f / 128.0f) + 1e-6f);
            const f32x4 gg = *(const f32x4*)(P + (size_t)tok * PW + P_GG + h * 128 + 4 * j);
            f32x4 o;
#pragma unroll
            for (int e = 0; e < 4; ++e) o[e] = x[e] * rs * g4[e] * siluf_(gg[e]);
            u32x2 w; w.x = cvt_pk_bf16(o[0], o[1]); w.y = cvt_pk_bf16(o[2], o[3]);
            *(u32x2*)(Og + (size_t)tok * 2048 + h * 128 + 4 * j) = w; } }
        __syncthreads();
    }
}

__device__ __forceinline__ float dpp_sum8(float x) {
    int xi = __builtin_bit_cast(int, x);
    x += __builtin_bit_cast(float, __builtin_amdgcn_update_dpp(0, xi, 0xB1, 0xf, 0xf, true));
    xi = __builtin_bit_cast(int, x);
    x += __builtin_bit_cast(float, __builtin_amdgcn_update_dpp(0, xi, 0x4E, 0xf, 0xf, true));
    xi = __builtin_bit_cast(int, x);
    x += __builtin_bit_cast(float, __builtin_amdgcn_update_dpp(0, xi, 0x141, 0xf, 0xf, true));
    return x;
}
__device__ __forceinline__ void rwkv_scan_job(LAS unsigned char* lds, CPR p, int l, int job) {
    const int tid = tid_l(), wid = tid >> 6, lane = tid & 63, kp = lane & 7;
    const bool lat = job < 128; const int jj = lat ? job : job - 128;
    const int half = jj & 1, dir = (jj >> 1) & 1, h = (jj >> 2) & 7, b = jj >> 5;
    const int T = lat ? 1024 : 256, tok0 = lat ? NCTX + b * 1024 : b * 256;
    const float* __restrict__ scan = (const float*)(p.ws + WS_SCAN);
    float* __restrict__ yout = (float*)(p.ws + (dir ? WS_YB : WS_YF));
    LAS float* buf = (LAS float*)lds;
    const int nch = T / 32;
    const int woff = dir ? 384 : 320;
    if (wid >= 4) {
        const int lt = tid - 256;
        f32x4 A[14], B[14];
#define SC_GLOAD(R, c_) do { _Pragma("unroll") for (int r = 0; r < 14; ++r) { const int idx = lt + 256 * r; const int ss = idx / 112, e = idx - ss * 112; const int st = (c_) * 32 + ss; \
            const int tok = dir ? tok0 + T - 1 - st : tok0 + st; R[r] = *(const f32x4*)(scan + ((size_t)tok * 8 + h) * SB_STRIDE + e * 4); } } while (0)
#define SC_LSTORE(R, c_) do { _Pragma("unroll") for (int r = 0; r < 14; ++r) { const int idx = lt + 256 * r; *(LAS f32x4*)(buf + ((c_) & 1) * 14336 + idx * 4) = R[r]; } } while (0)
#define SC_STEP(c_, Rl, Rs) do { if ((c_) + 2 < nch) SC_GLOAD(Rl, (c_) + 2); if ((c_) + 1 < nch) SC_LSTORE(Rs, (c_) + 1); __syncthreads(); } while (0)
        SC_GLOAD(A, 0); SC_GLOAD(B, 1);
        SC_LSTORE(A, 0);
        __syncthreads();
        for (int c = 0; c < nch; c += 2) {
            SC_STEP(c, A, B);
            if (c + 1 < nch) SC_STEP(c + 1, B, A);
        }
#undef SC_GLOAD
#undef SC_LSTORE
#undef SC_STEP
    } else {
        const int v = half * 32 + wid * 8 + (lane >> 3);
        f32x4 s0 = (f32x4){0.f, 0.f, 0.f, 0.f}, s1 = (f32x4){0.f, 0.f, 0.f, 0.f};
        if (lat) { const float* sp = p.in[I_SR] + ((((((size_t)b * 2 + l) * 2 + dir) * 8 + h) * 64 + v) * 64) + kp * 8; s0 = *(const f32x4*)sp; s1 = *(const f32x4*)(sp + 4); }
        __syncthreads();
        __builtin_amdgcn_s_setprio(3);
        for (int c = 0; c < nch; ++c) {
          for (int hb = 0; hb < 2; ++hb) {
            const LAS float* bb = buf + (c & 1) * 14336 + hb * 7168;
            float ykeep = 0.f;
            f32x4 nr0, nr1, nk0, nk1, nkap0, nkap1, nka0, nka1, nw0, nw1; float nvv;
#define SC_LD(ss_) do { const LAS float* row = bb + (ss_) * 448 + kp * 8; nr0 = *(const LAS f32x4*)(row); nr1 = *(const LAS f32x4*)(row + 4); nk0 = *(const LAS f32x4*)(row + 64); nk1 = *(const LAS f32x4*)(row + 68); \
                nkap0 = *(const LAS f32x4*)(row + 192); nkap1 = *(const LAS f32x4*)(row + 196); nka0 = *(const LAS f32x4*)(row + 256); nka1 = *(const LAS f32x4*)(row + 260); \
                nw0 = *(const LAS f32x4*)(row + woff); nw1 = *(const LAS f32x4*)(row + woff + 4); nvv = bb[(ss_) * 448 + 128 + v]; } while (0)
            SC_LD(0);
#pragma unroll
            for (int ss = 0; ss < 16; ++ss) {
                const f32x4 r0 = nr0, r1 = nr1, k0 = nk0, k1 = nk1, kap0 = nkap0, kap1 = nkap1, ka0 = nka0, ka1 = nka1, w0 = nw0, w1 = nw1; const float vv = nvv;
                if (ss < 15) SC_LD(ss + 1);
                __builtin_amdgcn_sched_barrier(0);
                const f32x4 t0 = s0 * kap0 + s1 * kap1;
                const float sk = dpp_sum8((t0[0] + t0[1]) + (t0[2] + t0[3]));
                s0 = s0 * w0 + (k0 * vv - ka0 * sk); s1 = s1 * w1 + (k1 * vv - ka1 * sk);
                const f32x4 t1 = s0 * r0 + s1 * r1;
                const float y = dpp_sum8((t1[0] + t1[1]) + (t1[2] + t1[3]));
                ykeep = (kp == (ss & 7)) ? y : ykeep;
                if ((ss & 7) == 7) { const int st = c * 32 + hb * 16 + (ss & 8) + kp; const int tok = dir ? tok0 + T - 1 - st : tok0 + st; yout[(size_t)tok * 512 + h * 64 + v] = ykeep; }
            }
#undef SC_LD
          }
            __syncthreads();
        }
        __builtin_amdgcn_s_setprio(0);
        if (!lat) { float* sp = p.out + O_SR + ((((((size_t)b * 2 + l) * 2 + dir) * 8 + h) * 64 + v) * 64) + kp * 8; *(f32x4*)sp = s0; *(f32x4*)(sp + 4) = s1; }
    }
}
__device__ __forceinline__ void rwkv_scan_phase(LAS unsigned char* lds, CPR p, int l) {
    const int wg = blockIdx.x, nwg = gridDim.x;
    for (int j = 0; j < 640; ++j) {
        const int owner = (j < 128) ? (j % nwg) : (nwg > 128 ? 128 + (j - 128) % (nwg - 128) : j % nwg);
        if (owner == wg) rwkv_scan_job(lds, p, l, j);
    }
}
__device__ __forceinline__ void rwkv_post(CPR p, int l, int gwave, int nwave) {
    const int lane = tid_l() & 63;
    const float* __restrict__ scan = (const float*)(p.ws + WS_SCAN); const float* __restrict__ yf = (const float*)(p.ws + WS_YF); const float* __restrict__ yb = (const float*)(p.ws + WS_YB); const float* __restrict__ gout = (const float*)(p.ws + WS_GOUT);
    bf16_t* __restrict__ Y = (bf16_t*)(p.ws + WS_OATT) + 1536;
    const float* rho = p.in[I_RBONUS] + l * 512; const float* lw = p.in[I_RLNW] + l * 512; const float* lb = p.in[I_RLNB] + l * 512;
    f32x4 rh[2], w4[2], b4[2];
#pragma unroll
    for (int it = 0; it < 2; ++it) { const int c = 4 * (it * 64 + lane); rh[it] = *(const f32x4*)(rho + c); w4[it] = *(const f32x4*)(lw + c); b4[it] = *(const f32x4*)(lb + c); }
    for (int tok = gwave; tok < NTOK; tok += nwave) {
        f32x4 r[2], kk[2], vv[2], ys[2], go[2];
#pragma unroll
        for (int it = 0; it < 2; ++it) { const int c = 4 * (it * 64 + lane); const float* sb = scan + ((size_t)tok * 8 + (c >> 6)) * SB_STRIDE + (c & 63);
            r[it] = *(const f32x4*)sb; kk[it] = *(const f32x4*)(sb + 64); vv[it] = *(const f32x4*)(sb + 128);
            ys[it] = __builtin_nontemporal_load((const f32x4*)(yf + (size_t)tok * 512 + c)) + __builtin_nontemporal_load((const f32x4*)(yb + (size_t)tok * 512 + c)); go[it] = __builtin_nontemporal_load((const f32x4*)(gout + (size_t)tok * 512 + c)); }
#pragma unroll
        for (int it = 0; it < 2; ++it) { const int c = 4 * (it * 64 + lane);
            const f32x4 t = r[it] * kk[it] * rh[it];
            const float bs = dpp_sum16((t[0] + t[1]) + (t[2] + t[3]));
            const f32x4 y = ys[it] + vv[it] * bs;
            const float mean = dpp_sum16((y[0] + y[1]) + (y[2] + y[3])) * (1.0f / 64.0f); const f32x4 xc = y - mean;
            const float var = dpp_sum16((xc[0] * xc[0] + xc[1] * xc[1]) + (xc[2] * xc[2] + xc[3] * xc[3])) * (1.0f / 64.0f);
            const f32x4 o = (xc * rsqrtf(var + 64e-5f) * w4[it] + b4[it]) * go[it];
            u32x2 w; w.x = cvt_pk_bf16(o[0], o[1]); w.y = cvt_pk_bf16(o[2], o[3]);
            *(u32x2*)(Y + (size_t)tok * 2048 + c) = w; }
    }
}

__device__ __forceinline__ void conv_act_phase(CPR p, int l, int gtid, int gthreads) {
    const bf16_t* __restrict__ U = (const bf16_t*)(p.ws + WS_U); bf16_t* __restrict__ A = (bf16_t*)(p.ws + WS_ABF);
    const float* cw = p.in[I_FCW] + (size_t)l * 3 * FU; const float* cb = p.in[I_FCB] + (size_t)l * FU;
    for (int item = gtid; item < 256 * 688; item += gthreads) {
        const int vc = item % 688, tb = item / 688; const int c0 = vc * 8, t0 = tb * 32;
        float wv[3][8], wg[3][8], bv[8], bg[8];
#pragma unroll
        for (int e = 0; e < 8; ++e) { bv[e] = cb[c0 + e]; bg[e] = cb[FH + c0 + e];
#pragma unroll
            for (int k = 0; k < 3; ++k) { wv[k][e] = cw[k * FU + c0 + e]; wg[k][e] = cw[k * FU + FH + c0 + e]; } }
        const int T = t0 < NCTX ? 256 : 1024; const int tin = t0 < NCTX ? (t0 & 255) : ((t0 - NCTX) & 1023);
        u32x4 pv, pg, cv, cgv, nv, ng; const u32x4 z = (u32x4){0u, 0u, 0u, 0u};
        pv = tin > 0 ? __builtin_nontemporal_load((const u32x4*)(U + (size_t)(t0 - 1) * FU + c0)) : z; pg = tin > 0 ? __builtin_nontemporal_load((const u32x4*)(U + (size_t)(t0 - 1) * FU + FH + c0)) : z;
        cv = __builtin_nontemporal_load((const u32x4*)(U + (size_t)t0 * FU + c0)); cgv = __builtin_nontemporal_load((const u32x4*)(U + (size_t)t0 * FU + FH + c0));
#pragma unroll 1
        for (int i4 = 0; i4 < 32; i4 += 4) {
            u32x4 nv4[4], ng4[4];
#pragma unroll
            for (int q = 0; q < 4; ++q) { const int i = i4 + q; const int t = t0 + i; const bool hn = (tin + i) < T - 1;
                nv4[q] = hn ? __builtin_nontemporal_load((const u32x4*)(U + (size_t)(t + 1) * FU + c0)) : z; ng4[q] = hn ? __builtin_nontemporal_load((const u32x4*)(U + (size_t)(t + 1) * FU + FH + c0)) : z; }
#pragma unroll
            for (int q = 0; q < 4; ++q) { const int t = t0 + i4 + q; nv = nv4[q]; ng = ng4[q];
                float ov[8];
#pragma unroll
                for (int e = 0; e < 8; ++e) { const int wi = e >> 1; const bool hi = e & 1;
                    auto ex = [&](const u32x4& qq) { const unsigned w = qq[wi]; return __uint_as_float(hi ? (w & 0xffff0000u) : (w << 16)); };
                    const float val = wv[0][e] * ex(pv) + wv[1][e] * ex(cv) + wv[2][e] * ex(nv) + bv[e];
                    const float gat = wg[0][e] * ex(pg) + wg[1][e] * ex(cgv) + wg[2][e] * ex(ng) + bg[e];
                    ov[e] = siluf_(gat) * val; }
                u32x4 w; w.x = cvt_pk_bf16(ov[0], ov[1]); w.y = cvt_pk_bf16(ov[2], ov[3]); w.z = cvt_pk_bf16(ov[4], ov[5]); w.w = cvt_pk_bf16(ov[6], ov[7]);
                *(u32x4*)(A + (size_t)t * FH + c0) = w;
                pv = cv; pg = cgv; cv = nv; cgv = ng; }
        }
    }
}

#define XB_TMO      128
#define XB_XCNT(j)  (256  + 64 * (j))
#define XB_XSUB(j)  (1280 + 64 * (j))
#define XB_XGEN(j)  (2304 + 64 * (j))
#define XB_TOP      3328
#define XB_TOPGEN   3392
#define XCD_BAR_WORDS 3456
#define XB_SPIN_CAP (1u << 22)
__device__ __forceinline__ unsigned xb_ld(unsigned* p)              { return __hip_atomic_load(p, __ATOMIC_RELAXED, __HIP_MEMORY_SCOPE_AGENT); }
__device__ __forceinline__ unsigned xb_add(unsigned* p, unsigned v) { return __hip_atomic_fetch_add(p, v, __ATOMIC_RELAXED, __HIP_MEMORY_SCOPE_AGENT); }
__device__ __forceinline__ unsigned xb_xcc_id() { return (unsigned)__builtin_amdgcn_s_getreg((3 << 11) | 20) & 0xFu; }
#define XB_SPIN(cond, bar) do { unsigned _sp = 0; while (cond) { __builtin_amdgcn_s_sleep(1); \
    if ((++_sp & 255u) == 0u) { if (xb_ld(&(bar)[XB_TMO])) break; if (_sp > XB_SPIN_CAP) { atomicAdd(&(bar)[XB_TMO], 1u); break; } } } } while (0)
struct XcdBarrier { unsigned* bar; unsigned x; volatile LAS unsigned* st; };
__device__ __forceinline__ void xcd_barrier_post(unsigned* bar) { if (threadIdx.x == 0) (void)xb_add(&bar[XB_XCNT(xb_xcc_id())], 1u); }
__device__ __forceinline__ void xcd_barrier_complete(unsigned* bar, unsigned x, unsigned& nloc, unsigned& nx) {
    const unsigned G = gridDim.x * gridDim.y * gridDim.z;
    unsigned sum, cnt, mine, sp = 0u;
    for (;;) {
        sum = 0u; cnt = 0u; mine = 0u;
#pragma unroll
        for (unsigned j = 0; j < 16; ++j) { const unsigned c = xb_ld(&bar[XB_XCNT(j)]); sum += c; cnt += (c > 0u) ? 1u : 0u; mine = (j == x) ? c : mine; }
        if (sum == G) break;
        __builtin_amdgcn_s_sleep(1);
        if ((++sp & 255u) == 0u) { if (xb_ld(&bar[XB_TMO])) break; if (sp > XB_SPIN_CAP) { atomicAdd(&bar[XB_TMO], 1u); break; } }
    }
    nloc = mine > 0u ? mine : 1u; nx = cnt > 0u ? cnt : 1u;
}
__device__ __forceinline__ void xcd_barrier(const XcdBarrier& b) {
    asm volatile("s_waitcnt vmcnt(0)" ::: "memory");
    __syncthreads();
    if (threadIdx.x == 0) {
        unsigned* bar = b.bar;
        __builtin_amdgcn_s_waitcnt(0);
        unsigned nloc = b.st[0], nx = b.st[1];
        if (nloc == 0u) { xcd_barrier_complete(bar, b.x, nloc, nx); b.st[0] = nloc; b.st[1] = nx; }
        const unsigned old = xb_add(&bar[XB_XSUB(b.x)], 1u);
        const unsigned gen = old / nloc;
        if (old + 1u == (gen + 1u) * nloc) {
            __builtin_amdgcn_fence(__ATOMIC_RELEASE, "agent");
            asm volatile("s_waitcnt vmcnt(0)" ::: "memory");
            const unsigned og = xb_add(&bar[XB_TOP], 1u);
            const unsigned tg = og / nx;
            if (og + 1u == (tg + 1u) * nx) xb_add(&bar[XB_TOPGEN], 1u);
            else XB_SPIN(xb_ld(&bar[XB_TOPGEN]) == tg, bar);
            __builtin_amdgcn_fence(__ATOMIC_ACQUIRE, "agent");
            xb_add(&bar[XB_XGEN(b.x)], 1u);
            asm volatile("s_waitcnt vmcnt(0)" ::: "memory");
        } else {
            XB_SPIN(xb_ld(&bar[XB_XGEN(b.x)]) == gen, bar);
            __builtin_amdgcn_fence(__ATOMIC_ACQUIRE, "agent");
            asm volatile("s_waitcnt vmcnt(0)" ::: "memory");
        }
    }
    __syncthreads();
}

__device__ __forceinline__ void tail_wgs(int nunits, int& tw, int& tn) {
    const int G = (int)gridDim.x, c = (int)blockIdx.x, rem = nunits % G;
    if (rem == 0) { tw = c; tn = G; } else { tn = G - rem; tw = (c >= rem) ? c - rem : -1; }
}
#ifndef PH_MASK
#define PH_MASK 0xFFFFFFFFu
#endif
#define PH(b) if (PH_MASK & (1u << (b)))
__device__ __forceinline__ CPR PPf() { const __attribute__((address_space(4))) Params* q = (const __attribute__((address_space(4))) Params*)__builtin_amdgcn_kernarg_segment_ptr(); asm volatile("" : "+s"(q)); return *q; }
#define PP PPf()
__global__ void __launch_bounds__(512, 2) fwd_megakernel(Params p_unused) {
    extern __shared__ __attribute__((aligned(16))) unsigned char shm[];
    LAS unsigned char* lds = (LAS unsigned char*)shm;
    cg::grid_group grid = cg::this_grid();
#define WGI ((int)blockIdx.x)
#define NWG ((int)gridDim.x)
#define GTID ((int)(blockIdx.x * 512 + tid_l()))
#define GTHREADS ((int)(gridDim.x * 512))
#define GWAVE ((int)(blockIdx.x * 8 + (tid_l() >> 6)))
#define NWAVE ((int)(gridDim.x * 8))
    { unsigned* bar = (unsigned*)(PP.ws + WS_BAR); if (blockIdx.x == 0) for (int i = threadIdx.x; i < XCD_BAR_WORDS; i += 512) bar[i] = 0u;
      if (threadIdx.x < 4) ((volatile LAS unsigned*)(lds + LDS_BYTES - 16))[threadIdx.x] = 0u; }
#define GSYNC() do { XcdBarrier xb_; xb_.bar = (unsigned*)(PP.ws + WS_BAR); xb_.x = xb_xcc_id(); xb_.st = (volatile LAS unsigned*)(lds + LDS_BYTES - 16); xcd_barrier(xb_); } while (0)
    PH(0) mod_phase(PP, (LAS float*)lds, WGI, NWG);
#pragma unroll 1
    for (int l = 0; l < 2; ++l) {
        PH(1) { CPR p = PP; bf16_t* W = (bf16_t*)(p.ws + WS_W);
            convert_job((LAS float*)lds, p.in[I_WIN] + (size_t)l * 2048 * 11616, (bf16_t*)((char*)W + W_IN), 2048, 11616, NIN_PAD, 1, WGI, NWG);
            convert_job((LAS float*)lds, p.in[I_WBRA] + (size_t)l * 1024 * 2048, (bf16_t*)((char*)W + W_BRA), 1024, 2048, 2048, 0, (WGI + 64) % NWG, NWG, 2048);
            convert_job((LAS float*)lds, p.in[I_WBRG] + (size_t)l * 512 * 2048, (bf16_t*)((char*)W + W_BRA) + 1024, 512, 2048, 2048, 0, (WGI + 128) % NWG, NWG, 2048);
            convert_job((LAS float*)lds, p.in[I_WBRR] + (size_t)l * 512 * 2048, (bf16_t*)((char*)W + W_BRA) + 1536, 512, 2048, 2048, 0, (WGI + 192) % NWG, NWG, 2048);
            convert_job((LAS float*)lds, p.in[I_WOUT] + (size_t)l * 2048 * 2048, (bf16_t*)((char*)W + W_OUT), 2048, 2048, 2048, 0, WGI, NWG);
            convert_lr(p, l, (bf16_t*)((char*)W + W_LR), GTID, GTHREADS); }
        if (l == 0) { grid.sync(); xcd_barrier_post((unsigned*)(PP.ws + WS_BAR)); }
        PH(2) { CPR p = PP; norm_phase(p, l, l == 0, p.in[I_NMIX] + l * DM, 0, 1, GWAVE, NWAVE); }
        GSYNC();
        PH(3) { CPR p = PP; EpiIn E; E.P = (float*)(p.ws + WS_P); E.G = (bf16_t*)(p.ws + WS_G); run_gemm(lds, (const bf16_t*)(p.ws + WS_H), (const bf16_t*)(p.ws + WS_W + W_IN), NIN_PAD, 2048, E); }
        GSYNC();
        PH(4) prep_phase(PP, l, GWAVE, NWAVE);
        GSYNC();
        PH(5) attn_phase(PP);
        PH(6) gla_g1(lds, PP, l);
        PH(7) { CPR p = PP; EpiLr E; E.scan = (float*)(p.ws + WS_SCAN); E.gout = (float*)(p.ws + WS_GOUT); E.w0 = p.in[I_RW0] + l * 1024; E.a0 = p.in[I_RA0] + l * 512; E.alpha = p.in[I_RALPHA] + l * 512;
          run_gemm(lds, (const bf16_t*)(p.ws + WS_ALR), (const bf16_t*)(p.ws + WS_W + W_LR), 2048, 384, E); }
        GSYNC();
        PH(8) gla_g2(PP, l, GTID, GTHREADS);
        PH(9) rwkv_scan_phase(lds, PP, l);
        GSYNC();
        PH(10) gla_g3(lds, PP, l);
        PH(11) rwkv_post(PP, l, GWAVE, NWAVE);
        GSYNC();
        PH(12) { CPR p = PP; EpiBrF E; E.merged = (bf16_t*)(p.ws + WS_MERGED); E.G = (const bf16_t*)(p.ws + WS_G);
          run_gemm(lds, (const bf16_t*)(p.ws + WS_OATT), (const bf16_t*)(p.ws + WS_W + W_BRA), 2048, 2048, E); }
        GSYNC();
        PH(13) { CPR p = PP; EpiRes E; E.x = p.out + O_X; E.gate = (const float*)(p.ws + WS_MOD) + (size_t)l * 5 * 12288 + 2 * 2048; E.xin0 = (l == 0) ? p.in[I_XP] : nullptr; E.xin1 = p.in[I_XS];
          run_gemm(lds, (const bf16_t*)(p.ws + WS_MERGED), (const bf16_t*)(p.ws + WS_W + W_OUT), 2048, 2048, E); }
        GSYNC();
        PH(16) { CPR p = PP; bf16_t* W = (bf16_t*)(p.ws + WS_W);
            convert_job((LAS float*)lds, p.in[I_FUP] + (size_t)l * 2048 * FU, (bf16_t*)((char*)W + W_UP), 2048, FU, FU, 0, WGI, NWG);
 }
        PH(17) { CPR p = PP; norm_phase(p, l, false, p.in[I_NFFN] + l * DM, 3, 4, GWAVE, NWAVE); }
        GSYNC();
        PH(15) { CPR p = PP; EpiUp E; E.U = (bf16_t*)(p.ws + WS_U); run_gemm(lds, (const bf16_t*)(p.ws + WS_H), (const bf16_t*)(p.ws + WS_W + W_UP), FU, 2048, E); }
        PH(16) { CPR p = PP; bf16_t* W = (bf16_t*)(p.ws + WS_W); int tw, tn; tail_wgs(32 * (FU / 256), tw, tn);
            if (tw >= 0) convert_job((LAS float*)lds, p.in[I_FDOWN] + (size_t)l * FH * 2048, (bf16_t*)((char*)W + W_DOWN), FH, 2048, 2048, 0, tw, tn); }
        GSYNC();
        PH(14) conv_act_phase(PP, l, GTID, GTHREADS);
        GSYNC();
        PH(18) { CPR p = PP; EpiRes E; E.x = p.out + O_X; E.gate = (const float*)(p.ws + WS_MOD) + (size_t)l * 5 * 12288 + 5 * 2048; E.xin0 = nullptr; E.xin1 = nullptr;
          run_gemm(lds, (const bf16_t*)(p.ws + WS_ABF), (const bf16_t*)(p.ws + WS_W + W_DOWN), 2048, FH, E); }
        GSYNC();
    }
}

extern "C" void kernel_launch(void* const* d_in, const int* in_sizes, int n_in, void* d_out, int out_size, void* d_ws, size_t ws_size, hipStream_t stream) {
    static int grid_blocks = 0;
    if (grid_blocks == 0) {
        if (n_in != 37 || ws_size < WS_END) { fprintf(stderr, "kernel_launch: unexpected n_in %d / ws %zu (need %zu)\n", n_in, ws_size, (size_t)WS_END); grid_blocks = -1; return; }
        int dev = 0, cus = 0, per_cu = 0;
        hipGetDevice(&dev);
        hipDeviceGetAttribute(&cus, hipDeviceAttributeMultiprocessorCount, dev);
        hipFuncSetAttribute((const void*)fwd_megakernel, hipFuncAttributeMaxDynamicSharedMemorySize, LDS_BYTES);
        hipOccupancyMaxActiveBlocksPerMultiprocessor(&per_cu, (const void*)fwd_megakernel, 512, LDS_BYTES);
        if (per_cu < 1) { fprintf(stderr, "kernel_launch: occupancy query says %d blocks per CU\n", per_cu); grid_blocks = -1; return; }
        grid_blocks = cus;
    }
    if (grid_blocks < 0) return;
    Params p{};
    for (int i = 0; i < 37; ++i) p.in[i] = (const float*)d_in[i];
    p.out = (float*)d_out; p.ws = (unsigned char*)d_ws;
    void* args[] = {&p};
    hipError_t e = hipLaunchCooperativeKernel((void*)fwd_megakernel, dim3(grid_blocks), dim3(512), args, LDS_BYTES, stream);
    if (e != hipSuccess) fprintf(stderr, "cooperative launch failed: %s (grid %d)\n", hipGetErrorString(e), grid_blocks);
}
```

```cpp
#include <hip/hip_runtime.h>
#include <hip/hip_cooperative_groups.h>
#include <cstdio>
namespace cg = cooperative_groups;
__device__ __forceinline__ int tid_l() { int t = (int)threadIdx.x; asm volatile("" : "+v"(t)); __builtin_assume(t >= 0 && t < 512); return t; }
namespace pg8 {
#define PG8_LAS __attribute__((address_space(3)))
typedef unsigned short bf16_t;
typedef short bf16x8 __attribute__((ext_vector_type(8)));
typedef float f32x4 __attribute__((ext_vector_type(4)));
typedef unsigned u32x4 __attribute__((ext_vector_type(4)));
constexpr int BM = 256, BK = 64, HALF = 128, HTB = HALF * BK * 2  , STAGE_BYTES = 8 * HTB, NXCD = 8, WGM = 8;

__host__ __device__ __forceinline__ int lds_byte(int r, int c) { const int st = (r >> 4) * 2 + (c >> 5), rr = r & 15, cc = c & 31, ob = rr * 64 + cc * 2; return st * 1024 + (ob ^ (((ob >> 9) & 1) << 5)); }
__host__ __device__ __forceinline__ void stage_rc(int b, int& R, int& C) { const int st = b / 1024, sb = b % 1024, swz = sb ^ (((sb >> 9) & 1) << 5); R = (st >> 1) * 16 + swz / 64; C = (st & 1) * 32 + (swz % 64) / 2; }
__host__ __device__ __forceinline__ int perm32(int rho) { const int n = rho >> 4, i = rho & 15; return 8 * (i >> 2) + 4 * n + (i & 3); }

struct Unit { int pm, pn; };
struct Gemm { const bf16_t* A; const bf16_t* Bt; int M, N, K; };

struct StaticOrder {
    int nM, nN, nwg, G, c;
    __host__ __device__ void init(int M, int N, int G_, int c_) { nM = M / BM; nN = N / BM; nwg = nM * nN; G = G_; c = c_; }
    __device__ bool next(int i, Unit& u) const {
        const long L = (long)i * G + c; if (L >= nwg) return false;
        int wgid = (int)L; { const int q = nwg / NXCD, r = nwg % NXCD, xcd = wgid % NXCD, off = wgid / NXCD; wgid = (xcd < r ? xcd * (q + 1) : r * (q + 1) + (xcd - r) * q) + off; }
        const int nig = WGM * nN, gid = wgid / nig, fm = gid * WGM, gsz = (nM - fm) < WGM ? (nM - fm) : WGM;
        u.pm = __builtin_amdgcn_readfirstlane(fm + ((wgid % nig) % gsz)); u.pn = __builtin_amdgcn_readfirstlane((wgid % nig) / gsz); return true;
    }
    __device__ __forceinline__ void a_ready(const Unit&) const {}
    __device__ __forceinline__ void done(const Unit&) const {}
};
__device__ __forceinline__ unsigned cvt_pk_bf16(float lo, float hi) { unsigned r; asm volatile("s_nop 1\n\tv_cvt_pk_bf16_f32 %0, %1, %2" : "=v"(r) : "v"(lo), "v"(hi));     return r; }
typedef float f32x2 __attribute__((ext_vector_type(2)));
template <class Epi, class Sched, bool STAMP = false>
__device__ __forceinline__ void gemm_phase(PG8_LAS unsigned char* lds, const Gemm g, const Sched& S, const Epi& E, unsigned long long* stamps) {
    const int tid = tid_l(), wid = __builtin_amdgcn_readfirstlane(tid >> 6), lane = tid & 63, wr = wid >> 2, wc = wid & 3, fr = lane & 15, fq = lane >> 4;
    const int K = g.K, nt = K / BK;
    int ts_lo = 0, ts_hi = 0, nts = 0; const unsigned long long rt_entry = STAMP ? (unsigned long long)wall_clock64() : 0ull;
#define PG8_STAMP() do { if (STAMP && wid == 0 && nts < 64) { const unsigned long long _c = (unsigned long long)clock64(); \
        ts_lo = (lane == nts) ? (int)(unsigned)_c : ts_lo; ts_hi = (lane == nts) ? (int)(unsigned)(_c >> 32) : ts_hi; ++nts; } } while (0)
    PG8_STAMP();
    unsigned voffA[2], voffB[2];
#pragma unroll
    for (int i = 0; i < 2; ++i) { int R, C; stage_rc(tid * 16 + i * 8192, R, C); const int Rb = Epi::PERM ? ((R & ~31) + perm32(R & 31)) : R;
        voffA[i] = (unsigned)(R * K + C) * 2u; voffB[i] = (unsigned)(Rb * K + C) * 2u; }
    const size_t kstep = (size_t)(BK * 2);
    const size_t hstep = (size_t)HALF * K * 2;
    const size_t tstep = 2 * hstep;
    const unsigned ldsw = (unsigned)wid * 1024u;
    const int aoff = lds_byte(wr * 64 + fr, fq * 8), boff = lds_byte(wc * 32 + fr, fq * 8);
#define PG8_SA(b, h) (((b) * 2 + (h)) * HTB)
#define PG8_SB(b, h) ((4 + (b) * 2 + (h)) * HTB)
#define PG8_STAGE(bufoff, gbase, voff) do { _Pragma("unroll") for (int _i = 0; _i < 2; ++_i) \
        __builtin_amdgcn_global_load_lds((const unsigned*)((const char*)(gbase) + (voff)[_i]), (PG8_LAS unsigned*)(lds + (bufoff) + ldsw + _i * 8192), 16, 0, 0); } while (0)
#define PG8_LDA(dst, b, h) do { _Pragma("unroll") for (int m = 0; m < 4; ++m) _Pragma("unroll") for (int k = 0; k < 2; ++k) dst[m][k] = *(const PG8_LAS bf16x8*)(lds + PG8_SA(b, h) + aoff + m * 2048 + k * 1024); } while (0)
#define PG8_LDB(dst, b, h) do { _Pragma("unroll") for (int n = 0; n < 2; ++n) _Pragma("unroll") for (int k = 0; k < 2; ++k) dst[n][k] = *(const PG8_LAS bf16x8*)(lds + PG8_SB(b, h) + boff + n * 2048 + k * 1024); } while (0)
#define PG8_MMA(ai, bj, At, Bt) do { __builtin_amdgcn_s_setprio(1); _Pragma("unroll") for (int m = 0; m < 4; ++m) _Pragma("unroll") for (int n = 0; n < 2; ++n) _Pragma("unroll") for (int k = 0; k < 2; ++k) \
        acc[ai][bj][m][n] = __builtin_amdgcn_mfma_f32_16x16x32_bf16(Bt[n][k], At[m][k], acc[ai][bj][m][n], 0, 0, 0); __builtin_amdgcn_s_setprio(0); } while (0)
#define PG8_WAIT_V(n) asm volatile("s_waitcnt vmcnt(" #n ")" ::: "memory")
#define PG8_WAIT_L(n) asm volatile("s_waitcnt lgkmcnt(" #n ")" ::: "memory")
#define PG8_BAR __builtin_amdgcn_s_barrier()
#define PG8_SCHED __builtin_amdgcn_sched_barrier(0)
    Unit cur, nxt; int ui = 0;
    if (!S.next(0, cur)) return;
    f32x4 acc[2][2][4][2];
#pragma unroll
    for (int a = 0; a < 2; ++a)
#pragma unroll
        for (int b = 0; b < 2; ++b)
#pragma unroll
            for (int m = 0; m < 4; ++m)
#pragma unroll
                for (int n = 0; n < 2; ++n) acc[a][b][m][n] = (f32x4){0.f, 0.f, 0.f, 0.f};
    bf16x8 At[4][2], B0[2][2], B1[2][2];
    const char* cA = (const char*)g.A + (size_t)cur.pm * tstep; const char* cB = (const char*)g.Bt + (size_t)cur.pn * tstep;
    S.a_ready(cur);
    PG8_STAGE(PG8_SB(0, 0), cB, voffB); PG8_STAGE(PG8_SA(0, 0), cA, voffA); PG8_STAGE(PG8_SB(0, 1), cB + hstep, voffB); PG8_STAGE(PG8_SA(0, 1), cA + hstep, voffA);
    if (wr == 1) PG8_BAR;
    PG8_WAIT_V(4); PG8_BAR;
    PG8_STAGE(PG8_SB(1, 0), cB + kstep, voffB); PG8_STAGE(PG8_SA(1, 0), cA + kstep, voffA); PG8_STAGE(PG8_SB(1, 1), cB + hstep + kstep, voffB);
    PG8_WAIT_V(6); PG8_BAR;
    PG8_STAMP();
    for (;;) {
        const bool has_next = S.next(ui + 1, nxt);
        const char* nA = has_next ? (const char*)g.A + (size_t)nxt.pm * tstep : cA; const char* nB = has_next ? (const char*)g.Bt + (size_t)nxt.pn * tstep : cB;
        for (int t = 0; t < nt; t += 2) {
            const bool last = (t == nt - 2);
            const char* a1 = cA + (size_t)(t + 1) * kstep;
            const char* a2 = last ? nA : cA + (size_t)(t + 2) * kstep; const char* b2 = last ? nB : cB + (size_t)(t + 2) * kstep;
            const char* a3 = a2 + kstep; const char* b3 = b2 + kstep;
            if (last && has_next) S.a_ready(nxt);
            if constexpr (Epi::HAS_MID) { if (E.mid_at(t)) E.mid(acc, cur, t, wr, wc, fr, fq); }
            PG8_LDB(B0, 0, 0); PG8_SCHED; PG8_LDA(At, 0, 0); PG8_STAGE(PG8_SA(1, 1), a1 + hstep, voffA);
            PG8_WAIT_L(8); PG8_BAR; PG8_WAIT_L(0); PG8_MMA(0, 0, At, B0); PG8_BAR; PG8_SCHED;
            PG8_LDB(B1, 0, 1); PG8_STAGE(PG8_SB(0, 0), b2, voffB);
            PG8_BAR; PG8_WAIT_L(0); PG8_MMA(0, 1, At, B1); PG8_BAR;
            PG8_LDA(At, 0, 1); PG8_STAGE(PG8_SA(0, 0), a2, voffA);
            PG8_BAR; PG8_WAIT_L(0); PG8_MMA(1, 0, At, B0); PG8_BAR; PG8_SCHED;
            PG8_STAGE(PG8_SB(0, 1), b2 + hstep, voffB);
            PG8_WAIT_V(6); PG8_BAR; PG8_MMA(1, 1, At, B1); PG8_BAR;
            PG8_LDB(B0, 1, 0); PG8_SCHED; PG8_LDA(At, 1, 0); PG8_STAGE(PG8_SA(0, 1), a2 + hstep, voffA);
            PG8_WAIT_L(8); PG8_BAR; PG8_WAIT_L(0); PG8_MMA(0, 0, At, B0); PG8_BAR; PG8_SCHED;
            PG8_LDB(B1, 1, 1); PG8_STAGE(PG8_SB(1, 0), b3, voffB);
            PG8_BAR; PG8_WAIT_L(0); PG8_MMA(0, 1, At, B1); PG8_BAR;
            PG8_LDA(At, 1, 1); PG8_STAGE(PG8_SA(1, 0), a3, voffA);
            PG8_BAR; PG8_WAIT_L(0); PG8_MMA(1, 0, At, B0); PG8_BAR; PG8_SCHED;
            PG8_STAGE(PG8_SB(1, 1), b3 + hstep, voffB);
            PG8_WAIT_V(6); PG8_BAR; PG8_MMA(1, 1, At, B1); PG8_BAR;
        }
        PG8_STAMP();
        if constexpr (!Epi::AFTER_DRAIN) { E(acc, cur, wr, wc, fr, fq); S.done(cur); }
        PG8_STAMP();
        if (!has_next) break;
#pragma unroll
        for (int a = 0; a < 2; ++a)
#pragma unroll
            for (int b = 0; b < 2; ++b)
#pragma unroll
                for (int m = 0; m < 4; ++m)
#pragma unroll
                    for (int n = 0; n < 2; ++n) acc[a][b][m][n] = (f32x4){0.f, 0.f, 0.f, 0.f};
        cur = nxt; cA = nA; cB = nB; ++ui;
    }
    PG8_WAIT_V(0);
    if (wr == 0) PG8_BAR;
    PG8_BAR;
    if constexpr (Epi::AFTER_DRAIN) { E.fused(acc, cur, wr, wc, fr, fq, lds, wid, lane); S.done(cur); }
    PG8_STAMP();
    if (STAMP && wid == 0) { stamps[lane] = lane < nts ? (((unsigned long long)(unsigned)ts_hi << 32) | (unsigned)ts_lo) : 0ull;
        if (lane == 62) stamps[62] = rt_entry; if (lane == 63) stamps[63] = (unsigned long long)wall_clock64(); }
#undef PG8_STAMP
#undef PG8_SA
#undef PG8_SB
#undef PG8_STAGE
#undef PG8_LDA
#undef PG8_LDB
#undef PG8_MMA
#undef PG8_WAIT_V
#undef PG8_WAIT_L
#undef PG8_BAR
#undef PG8_SCHED
}
}

#define LAS __attribute__((address_space(3)))
typedef unsigned short bf16_t;
typedef short bf16x8 __attribute__((ext_vector_type(8)));
typedef short bf16x4 __attribute__((ext_vector_type(4)));
typedef float f32x4 __attribute__((ext_vector_type(4)));
typedef float f32x2 __attribute__((ext_vector_type(2)));
typedef unsigned u32x4 __attribute__((ext_vector_type(4)));
typedef unsigned u32x2 __attribute__((ext_vector_type(2)));
using pg8::cvt_pk_bf16;

constexpr int DM = 2048, NTOK = 8192, NCTX = 4096;
constexpr int PW = 5888;
constexpr int P_AQ = 0, P_AK = 1024, P_AV = 1280, P_GQ = 1536, P_GK = 2048, P_GV = 2560, P_GG = 3072, P_GAD = 3584, P_RW = 3840;
constexpr int GW = 6144;
constexpr int NIN_PAD = 12032;
constexpr int FH = 5504, FU = 11008;
constexpr int SB_STRIDE = 448;
constexpr int LDS_BYTES = 147456;

constexpr size_t O_X = 0, O_CK = 16777216, O_CV = 18874368, O_SG = 20971520, O_SR = 25165824;

constexpr size_t MBy = 1048576;
constexpr size_t WS_W = 0;
constexpr size_t W_IN = 0, W_BRA = 49283072, W_BRG = 53477376, W_BRR = 55574528, W_OUT = 57671680, W_LR = 66060288;
constexpr size_t W_UP = 0, W_DOWN = 45088768;
constexpr size_t WS_A = 68 * MBy;
constexpr size_t WS_P = WS_A, WS_G = WS_A + 192937984, WS_U = WS_A;
constexpr size_t WS_B = WS_A + 280 * MBy;
constexpr size_t WS_SCAN = WS_B, WS_ALR = WS_B + 112 * MBy, WS_GOUT = WS_B + 118 * MBy;
constexpr size_t WS_ABF = WS_B, WS_MBUF = WS_B + 86 * MBy;
constexpr size_t WS_C = WS_B + 150 * MBy;
constexpr size_t WS_KVT = WS_C, WS_SST = WS_C + 64 * MBy, WS_DEC = WS_C + 96 * MBy, WS_YF = WS_C + 97 * MBy, WS_YB = WS_C + 113 * MBy;
constexpr size_t WS_D = WS_C + 129 * MBy;
constexpr size_t WS_H = WS_D, WS_MERGED = WS_D, WS_QB = WS_D + 32 * MBy, WS_KC = WS_D + 48 * MBy, WS_VTC = WS_D + 50 * MBy, WS_KL = WS_D + 52 * MBy, WS_VTL = WS_D + 55 * MBy,
                 WS_OATT = WS_D + 58 * MBy, WS_OGLA = WS_D + 74 * MBy, WS_YRW = WS_D + 82 * MBy, WS_MOD = WS_D + 90 * MBy;
constexpr size_t WS_BAR = WS_D + 90 * MBy + 786432;
constexpr size_t WS_GST = WS_D + 91 * MBy;
constexpr size_t WS_END = WS_GST + 48 * MBy;

struct Params { const float* in[37]; float* out; unsigned char* ws; };
typedef const __attribute__((address_space(4))) Params& CPR;
enum { I_XP = 0, I_XS, I_CK, I_CV, I_SG, I_SR, I_C, I_CCTX, I_WMOD, I_BMOD, I_NMIX, I_WIN, I_QN, I_KN, I_GAUP, I_GABIAS, I_GNORM, I_RMU, I_RW0, I_RWUP, I_RA0, I_RAUP, I_RGUP,
       I_RXI, I_RALPHA, I_RBONUS, I_RLNW, I_RLNB, I_WBRA, I_WBRG, I_WBRR, I_WOUT, I_NFFN, I_FUP, I_FCW, I_FCB, I_FDOWN };

__device__ __forceinline__ float wave_sum(float v) {
#pragma unroll
    for (int o = 32; o > 0; o >>= 1) v += __shfl_xor(v, o);
    return v;
}
__device__ __forceinline__ float frcp(float x) { return __builtin_amdgcn_rcpf(x); }
__device__ __forceinline__ float sigmoidf_(float x) { return frcp(1.0f + __expf(-x)); }
__device__ __forceinline__ float siluf_(float x) { return x * frcp(1.0f + __expf(-x)); }
__device__ __forceinline__ bf16_t f2bf(float f) { unsigned u = __float_as_uint(f); u += 0x7FFFu + ((u >> 16) & 1u); return (bf16_t)(u >> 16); }
__device__ __forceinline__ float bf2f(bf16_t b) { return __uint_as_float(((unsigned)b) << 16); }
__device__ __forceinline__ int kperm(int key, int d) { return ((((key >> 4) * 4 + (d >> 5)) * 4 + ((d & 31) >> 3)) * 16 + (key & 15)) * 8 + (d & 7); }
__device__ __forceinline__ float dpp_sum16(float x) {
    int xi = __builtin_bit_cast(int, x);
    x += __builtin_bit_cast(float, __builtin_amdgcn_update_dpp(0, xi, 0xB1, 0xf, 0xf, true));
    xi = __builtin_bit_cast(int, x);
    x += __builtin_bit_cast(float, __builtin_amdgcn_update_dpp(0, xi, 0x4E, 0xf, 0xf, true));
    xi = __builtin_bit_cast(int, x);
    x += __builtin_bit_cast(float, __builtin_amdgcn_update_dpp(0, xi, 0x141, 0xf, 0xf, true));
    xi = __builtin_bit_cast(int, x);
    x += __builtin_bit_cast(float, __builtin_amdgcn_update_dpp(0, xi, 0x140, 0xf, 0xf, true));
    return x;
}
__device__ __forceinline__ int mod_index(int tok) { return tok < NCTX ? 0 : 1 + ((tok - NCTX) >> 10); }

__device__ __forceinline__ int win_map(int n) {
    if (n < 3616) return n;
    if (n < 3840) return -1;
    if (n < 5696) return 3616 + (n - 3840);
    if (n < 5888) return -1;
    return 5472 + (n - 5888);
}
__device__ __forceinline__ void convert_job(LAS float* tile, const float* __restrict__ src, bf16_t* __restrict__ dst, int K, int Nsrc, int Ndst, int mode, int wg, int nwg, int ldd = 0) {
    if (ldd == 0) ldd = K;
    const int tid = tid_l();
    const int tk = K / 64, tn = Ndst / 256, nt = tk * tn;
    for (int t = wg; t < nt; t += nwg) {
        const int k0 = (t % tk) * 64, n0 = (t / tk) * 256;
        {
            const int c4 = tid & 63, i0 = tid >> 6;
            const int n = n0 + c4 * 4; const int on = mode ? win_map(n) : n;
            f32x4 v[8];
#pragma unroll
            for (int r = 0; r < 8; ++r) { const int i = i0 + 8 * r; v[r] = (on >= 0) ? __builtin_nontemporal_load((const f32x4*)(src + (size_t)(k0 + i) * Nsrc + on)) : (f32x4){0.f, 0.f, 0.f, 0.f}; }
#pragma unroll
            for (int r = 0; r < 8; ++r) { LAS float* tp = tile + (i0 + 8 * r) * 257 + c4 * 4; tp[0] = v[r][0]; tp[1] = v[r][1]; tp[2] = v[r][2]; tp[3] = v[r][3]; }
        }
        __syncthreads();
        {
            const int kp = tid & 7;
#pragma unroll
            for (int ps = 0; ps < 4; ++ps) { const int nl = ps * 64 + (tid >> 3); const LAS float* tp = tile + (kp * 8) * 257 + nl;
                u32x4 w; w.x = cvt_pk_bf16(tp[0], tp[257]); w.y = cvt_pk_bf16(tp[2 * 257], tp[3 * 257]); w.z = cvt_pk_bf16(tp[4 * 257], tp[5 * 257]); w.w = cvt_pk_bf16(tp[6 * 257], tp[7 * 257]);
                *(u32x4*)(dst + (size_t)(n0 + nl) * ldd + k0 + kp * 8) = w; }
        }
        __syncthreads();
    }
}
__device__ __forceinline__ void convert_lr(CPR p, int l, bf16_t* dst, int gtid, int gthreads) {
    const float* wup = p.in[I_RWUP] + (size_t)l * 2 * 64 * 512;
    const float* aup = p.in[I_RAUP] + (size_t)l * 64 * 512;
    const float* gup = p.in[I_RGUP] + (size_t)l * 128 * 512;
    for (int idx = gtid; idx < 2048 * 384; idx += gthreads) {
        const int n = idx / 384, k = idx - n * 384; float v = 0.f;
        if (n < 512) { if (k < 64) v = wup[(size_t)k * 512 + n]; }
        else if (n < 1024) { if (k >= 64 && k < 128) v = wup[(size_t)(64 + (k - 64)) * 512 + (n - 512)]; }
        else if (n < 1536) { if (k >= 128 && k < 192) v = aup[(size_t)(k - 128) * 512 + (n - 1024)]; }
        else { if (k >= 192 && k < 320) v = gup[(size_t)(k - 192) * 512 + (n - 1536)]; }
        dst[idx] = f2bf(v);
    }
}

__device__ __forceinline__ void mod_phase(CPR p, LAS float* lds, int wg, int nwg) {
    const int tid = tid_l();
    LAS float* sc = lds;
    LAS float* red = lds + 5 * 2048;
    for (int i = tid; i < 5 * 2048; i += 512) { const int j = i >> 11, k = i & 2047; const float c = (j == 0) ? p.in[I_CCTX][k] : p.in[I_C][(j - 1) * 2048 + k]; sc[i] = siluf_(c); }
    __syncthreads();
    float* mod = (float*)(p.ws + WS_MOD);
    for (int item = wg; item < 256; item += nwg) {
        const int l = item >> 7, col0 = (item & 127) * 96;
        const float* W = p.in[I_WMOD] + (size_t)l * 2048 * 12288;
        const int c4 = tid % 24, kg = tid / 24;
        if (kg < 16) {
            f32x4 acc[5];
#pragma unroll
            for (int j = 0; j < 5; ++j) acc[j] = (f32x4){0.f, 0.f, 0.f, 0.f};
            const float* wp = W + (size_t)(kg * 128) * 12288 + col0 + c4 * 4;
#pragma unroll 8
            for (int k = 0; k < 128; ++k) { const f32x4 w = __builtin_nontemporal_load((const f32x4*)(wp + (size_t)k * 12288));
#pragma unroll
                for (int j = 0; j < 5; ++j) acc[j] += w * sc[j * 2048 + kg * 128 + k]; }
#pragma unroll
            for (int j = 0; j < 5; ++j)
#pragma unroll
                for (int e = 0; e < 4; ++e) red[(kg * 5 + j) * 96 + c4 * 4 + e] = acc[j][e];
        }
        __syncthreads();
        if (tid < 480) { const int j = tid / 96, c = tid % 96; float s = p.in[I_BMOD][l * 12288 + col0 + c];
            for (int g = 0; g < 16; ++g) s += red[(g * 5 + j) * 96 + c];
            mod[((size_t)l * 5 + j) * 12288 + col0 + c] = s; }
        __syncthreads();
    }
}

__device__ __forceinline__ void norm_phase(CPR p, int l, bool first, const float* gamma, int sh_idx, int sc_idx, int gwave, int nwave) {
    const int lane = tid_l() & 63;
    float* x = p.out + O_X; bf16_t* H = (bf16_t*)(p.ws + WS_H);
    const float* mod = (const float*)(p.ws + WS_MOD) + (size_t)l * 5 * 12288;
    for (int tok = gwave; tok < NTOK; tok += nwave) {
        const float* src = first ? (tok < NCTX ? p.in[I_XP] + (size_t)tok * DM : p.in[I_XS] + (size_t)(tok - NCTX) * DM) : x + (size_t)tok * DM;
        const float* mj = mod + (size_t)mod_index(tok) * 12288;
        f32x4 v[8]; float ss = 0.f;
#pragma unroll
        for (int i = 0; i < 8; ++i) { v[i] = *(const f32x4*)(src + lane * 4 + i * 256); ss += v[i][0] * v[i][0] + v[i][1] * v[i][1] + v[i][2] * v[i][2] + v[i][3] * v[i][3]; }
        ss = wave_sum(ss);
        const float rs = rsqrtf(ss * (1.0f / 2048.0f) + 1e-6f);
#pragma unroll
        for (int i = 0; i < 8; ++i) { const int c = lane * 4 + i * 256;
            const f32x4 g = *(const f32x4*)(gamma + c), scv = *(const f32x4*)(mj + sc_idx * 2048 + c), shv = *(const f32x4*)(mj + sh_idx * 2048 + c);
            const f32x4 h = (v[i] * rs * g) * (scv + 1.0f) + shv;
            u32x2 w; w.x = cvt_pk_bf16(h[0], h[1]); w.y = cvt_pk_bf16(h[2], h[3]);
            *(u32x2*)(H + (size_t)tok * DM + c) = w;
 }
    }
}

template <class F> __device__ __forceinline__ void epi_loop(const f32x4 (&acc)[2][2][4][2], const pg8::Unit& u, int wr, int wc, int fr, int fq, F&& f) {
    asm volatile("" : "+v"(fr), "+v"(fq)); asm volatile("" : "+s"(wr), "+s"(wc));
#pragma unroll
    for (int ai = 0; ai < 2; ++ai)
#pragma unroll
        for (int m = 0; m < 4; ++m) { const int row = u.pm * 256 + ai * 128 + wr * 64 + m * 16 + fr;
#pragma unroll
            for (int bj = 0; bj < 2; ++bj)
#pragma unroll
                for (int n = 0; n < 2; ++n) { const int col = u.pn * 256 + bj * 128 + wc * 32 + n * 16 + 4 * fq; f(row, col, acc[ai][bj][m][n]); } }
}
#define EPI_BEGIN epi_loop(acc, u, wr, wc, fr, fq, [&](const int row, const int col, const f32x4 a) {
#define EPI_END });

struct EpiIn {
    static constexpr bool PERM = true, AFTER_DRAIN = false, HAS_MID = false;
    float* P; bf16_t* G;
    __device__ __forceinline__ void operator()(const f32x4 (&acc)[2][2][4][2], const pg8::Unit& u, int wr, int wc, int fr, int fq) const {
        asm volatile("" : "+v"(fr), "+v"(fq)); asm volatile("" : "+s"(wr), "+s"(wc));
#pragma unroll
        for (int ai = 0; ai < 2; ++ai)
#pragma unroll
            for (int m = 0; m < 4; ++m) { const int row = u.pm * 256 + ai * 128 + wr * 64 + m * 16 + fr;
#pragma unroll
                for (int bj = 0; bj < 2; ++bj) { const int col = u.pn * 256 + bj * 128 + wc * 32 + 8 * fq; const f32x4 v0 = acc[ai][bj][m][0], v1 = acc[ai][bj][m][1];
                    if (u.pn < 23) { float* pp = P + (size_t)row * PW + col; *(f32x4*)pp = v0; *(f32x4*)(pp + 4) = v1; }
                    else { u32x4 w; w.x = cvt_pk_bf16(v0[0], v0[1]); w.y = cvt_pk_bf16(v0[2], v0[3]); w.z = cvt_pk_bf16(v1[0], v1[1]); w.w = cvt_pk_bf16(v1[2], v1[3]);
                           *(u32x4*)(G + (size_t)row * GW + (col - 5888)) = w; } } }
    }
};
struct EpiUp {
    static constexpr bool PERM = true, AFTER_DRAIN = false, HAS_MID = false;
    bf16_t* U;
    __device__ __forceinline__ void operator()(const f32x4 (&acc)[2][2][4][2], const pg8::Unit& u, int wr, int wc, int fr, int fq) const {
        asm volatile("" : "+v"(fr), "+v"(fq)); asm volatile("" : "+s"(wr), "+s"(wc));
#pragma unroll
        for (int ai = 0; ai < 2; ++ai)
#pragma unroll
            for (int m = 0; m < 4; ++m) { const int row = u.pm * 256 + ai * 128 + wr * 64 + m * 16 + fr;
#pragma unroll
                for (int bj = 0; bj < 2; ++bj) { const int col = u.pn * 256 + bj * 128 + wc * 32 + 8 * fq; const f32x4 v0 = acc[ai][bj][m][0], v1 = acc[ai][bj][m][1];
                    u32x4 w; w.x = cvt_pk_bf16(v0[0], v0[1]); w.y = cvt_pk_bf16(v0[2], v0[3]); w.z = cvt_pk_bf16(v1[0], v1[1]); w.w = cvt_pk_bf16(v1[2], v1[3]);
                    *(u32x4*)(U + (size_t)row * FU + col) = w; } }
    }
};
struct EpiRes {
    static constexpr bool PERM = false, AFTER_DRAIN = false, HAS_MID = false;
    float* x; const float* gate;
    const float* xin0; const float* xin1;
    __device__ __forceinline__ void operator()(const f32x4 (&acc)[2][2][4][2], const pg8::Unit& u, int wr, int wc, int fr, int fq) const {
        EPI_BEGIN  const f32x4 g = *(const f32x4*)(gate + (size_t)mod_index(row) * 12288 + col); float* xp = x + (size_t)row * DM + col;
            const float* src = xin0 ? (row < NCTX ? xin0 + (size_t)row * DM + col : xin1 + (size_t)(row - NCTX) * DM + col) : xp;
            const f32x4 xv = *(const f32x4*)src; *(f32x4*)xp = xv + g * a;  EPI_END
    }
};
struct EpiBr {
    static constexpr bool PERM = false, AFTER_DRAIN = false, HAS_MID = false;
    float* Mb; bf16_t* merged; const bf16_t* G; int mode;
    __device__ __forceinline__ void operator()(const f32x4 (&acc)[2][2][4][2], const pg8::Unit& u, int wr, int wc, int fr, int fq) const {
        EPI_BEGIN  const u32x2 gw = *(const u32x2*)(G + (size_t)row * GW + mode * 2048 + col);
            f32x4 g; g[0] = sigmoidf_(__uint_as_float(gw.x << 16)); g[1] = sigmoidf_(__uint_as_float(gw.x & 0xffff0000u)); g[2] = sigmoidf_(__uint_as_float(gw.y << 16)); g[3] = sigmoidf_(__uint_as_float(gw.y & 0xffff0000u));
            float* mp = Mb + (size_t)row * DM + col; f32x4 r = g * a;
            if (mode > 0) r += *(const f32x4*)mp;
            if (mode < 2) *(f32x4*)mp = r;
            else { u32x2 w; w.x = cvt_pk_bf16(r[0], r[1]); w.y = cvt_pk_bf16(r[2], r[3]); *(u32x2*)(merged + (size_t)row * DM + col) = w; }  EPI_END
    }
};
struct EpiBrF {
    static constexpr bool PERM = false, AFTER_DRAIN = false, HAS_MID = true;
    bf16_t* merged; const bf16_t* G;
    __device__ __forceinline__ bool mid_at(int t) const { return t == 16 || t == 24; }
    static __device__ __forceinline__ float em(unsigned bits) { const float x = fminf(fmaxf(__uint_as_float(bits), -30.0f), 30.0f); return 1.0f + __expf(-x); }
    __device__ __forceinline__ void mid(f32x4 (&acc)[2][2][4][2], const pg8::Unit& u, int t, int wr, int wc, int fr, int fq) const {
        asm volatile("" : "+v"(fr), "+v"(fq)); asm volatile("" : "+s"(wr), "+s"(wc));
        const int gi = (t == 16) ? 0 : 1;
#pragma unroll
        for (int ai = 0; ai < 2; ++ai)
#pragma unroll
            for (int m = 0; m < 4; ++m) { const int row = u.pm * 256 + ai * 128 + wr * 64 + m * 16 + fr;
#pragma unroll
                for (int bj = 0; bj < 2; ++bj)
#pragma unroll
                    for (int n = 0; n < 2; ++n) { const int col = u.pn * 256 + bj * 128 + wc * 32 + n * 16 + 4 * fq;
                        const bf16_t* gp = G + (size_t)row * GW + gi * 2048 + col;
                        const u32x2 xa = *(const u32x2*)gp, xb = *(const u32x2*)(gp + 2048);
                        f32x4 r;
                        r[0] = em(xb.x << 16) * frcp(em(xa.x << 16)); r[1] = em(xb.x & 0xffff0000u) * frcp(em(xa.x & 0xffff0000u));
                        r[2] = em(xb.y << 16) * frcp(em(xa.y << 16)); r[3] = em(xb.y & 0xffff0000u) * frcp(em(xa.y & 0xffff0000u));
                        acc[ai][bj][m][n] *= r; } }
    }
    __device__ __forceinline__ void operator()(const f32x4 (&acc)[2][2][4][2], const pg8::Unit& u, int wr, int wc, int fr, int fq) const {
        EPI_BEGIN const u32x2 gw = *(const u32x2*)(G + (size_t)row * GW + 2 * 2048 + col);
            f32x4 r; r[0] = a[0] * frcp(em(gw.x << 16)); r[1] = a[1] * frcp(em(gw.x & 0xffff0000u)); r[2] = a[2] * frcp(em(gw.y << 16)); r[3] = a[3] * frcp(em(gw.y & 0xffff0000u));
            u32x2 w; w.x = cvt_pk_bf16(r[0], r[1]); w.y = cvt_pk_bf16(r[2], r[3]); *(u32x2*)(merged + (size_t)row * DM + col) = w; EPI_END
    }
};
struct EpiLr {
    static constexpr bool PERM = false, AFTER_DRAIN = false, HAS_MID = false;
    float* scan; float* gout; const float* w0; const float* a0; const float* alpha;
    __device__ __forceinline__ void operator()(const f32x4 (&acc)[2][2][4][2], const pg8::Unit& u, int wr, int wc, int fr, int fq) const {
        const int sect = u.pn >> 1;
        if (sect < 2) {
            EPI_BEGIN const int c = col & 511; float* sb = scan + ((size_t)row * 8 + (c >> 6)) * SB_STRIDE + (c & 63);
                const f32x4 b = *(const f32x4*)(w0 + sect * 512 + c); f32x4 w;
#pragma unroll
                for (int e = 0; e < 4; ++e) w[e] = __expf(-0.606531f * sigmoidf_(b[e] + a[e]));
                *(f32x4*)(sb + 320 + sect * 64) = w; EPI_END
        } else if (sect == 2) {
            EPI_BEGIN const int c = col & 511; float* sb = scan + ((size_t)row * 8 + (c >> 6)) * SB_STRIDE + (c & 63);
                const f32x4 b = *(const f32x4*)(a0 + c), al = *(const f32x4*)(alpha + c); const f32x4 rk = *(const f32x4*)(sb + 64), kap = *(const f32x4*)(sb + 192); f32x4 kk, ka;
#pragma unroll
                for (int e = 0; e < 4; ++e) { const float av = sigmoidf_(b[e] + a[e]); kk[e] = rk[e] * (1.0f + (av - 1.0f) * al[e]); ka[e] = kap[e] * av; }
                *(f32x4*)(sb + 64) = kk; *(f32x4*)(sb + 256) = ka; EPI_END
        } else {
            EPI_BEGIN const int c = col & 511; *(f32x4*)(gout + (size_t)row * 512 + c) = a; EPI_END
        }
    }
};

template <class Epi> __device__ __forceinline__ void run_gemm(LAS unsigned char* lds, const bf16_t* A, const bf16_t* Bt, int N, int K, const Epi& E) {
    asm volatile("" : "+s"(N)); asm volatile("" : "+s"(K));
    pg8::Gemm g; g.A = A; g.Bt = Bt; g.M = NTOK; g.N = N; g.K = K;
    pg8::StaticOrder S; S.init(NTOK, N, (int)gridDim.x, (int)blockIdx.x);
    pg8::gemm_phase<Epi, pg8::StaticOrder, false>(lds, g, S, E, nullptr);
    __syncthreads();
}

__device__ __forceinline__ void prep_phase(CPR p, int l, int gwave, int nwave) {
    const int lane = tid_l() & 63;
    const float* P = (const float*)(p.ws + WS_P);
    bf16_t* Qb = (bf16_t*)(p.ws + WS_QB); bf16_t* Kc = (bf16_t*)(p.ws + WS_KC); bf16_t* Vtc = (bf16_t*)(p.ws + WS_VTC); bf16_t* Kl = (bf16_t*)(p.ws + WS_KL); bf16_t* Vtl = (bf16_t*)(p.ws + WS_VTL);
    float* scan = (float*)(p.ws + WS_SCAN); bf16_t* Alr = (bf16_t*)(p.ws + WS_ALR);
    for (int it = gwave; it < 2048; it += nwave) {
        const int t = it & 255, h = (it >> 8) & 1, b = it >> 9;
        const size_t src = ((((size_t)b * 2 + l) * 2 + h) * 256 + t) * 128;
        const f32x2 kv = *(const f32x2*)(p.in[I_CK] + src + lane * 2), vv = *(const f32x2*)(p.in[I_CV] + src + lane * 2);
        *(unsigned*)(Kl + ((size_t)b * 2 + h) * 1280 * 128 + kperm(t, lane * 2)) = cvt_pk_bf16(kv[0], kv[1]);
        { const int kk = t & 31, pp = ((kk & 15) >> 2) * 8 + (kk >> 4) * 4 + (kk & 3); bf16_t* vt = Vtl + ((((size_t)b * 2 + h) * 40 + (t >> 5)) * 128) * 32 + pp;
          vt[(size_t)(lane * 2) * 32] = f2bf(vv[0]); vt[(size_t)(lane * 2 + 1) * 32] = f2bf(vv[1]); }
    }
    const float* qn = p.in[I_QN] + l * 128; const float* kn = p.in[I_KN] + l * 128;
    const float* mu = p.in[I_RMU] + l * 1856; const float* xi = p.in[I_RXI] + l * 512;
    const int hw = lane >> 5, j = lane & 31;
    const bool lowhalf = (j & 15) < 8;
    f32x4 inv4;
#pragma unroll
    for (int e = 0; e < 4; ++e) inv4[e] = exp2f(-(float)(2 * ((4 * j + e) & 31)) * (13.287712379549449f / 64.0f));
    const f32x4 qg = *(const f32x4*)(qn + 4 * j), kg = *(const f32x4*)(kn + 4 * j);
    for (int tok = gwave; tok < NTOK; tok += nwave) {
        const bool lat = tok >= NCTX;
        const int b = lat ? (tok - NCTX) >> 10 : tok >> 8, t = lat ? (tok - NCTX) & 1023 : tok & 255, T = lat ? 1024 : 256;
        const float* pr = P + (size_t)tok * PW;
        f32x4 cs = (f32x4){1.f, 1.f, 1.f, 1.f}, sn = (f32x4){0.f, 0.f, 0.f, 0.f};
        if (lat) { const float pos = (float)((j >> 4) == 0 ? (t >> 6) : (t & 63));
#pragma unroll
            for (int e = 0; e < 4; ++e) { const float ang = pos * inv4[e]; sn[e] = __sinf(ang); cs[e] = __cosf(ang); } }
        f32x4 xin[6];
#pragma unroll
        for (int s2 = 0; s2 < 6; ++s2) { const int slot = 2 * s2 + hw; const int col = slot < 8 ? P_AQ + slot * 128 : (slot < 10 ? P_AK + (slot - 8) * 128 : P_AV + (slot - 10) * 128); xin[s2] = *(const f32x4*)(pr + col + 4 * j); }
#pragma unroll
        for (int s2 = 0; s2 < 6; ++s2) {
            const int slot = 2 * s2 + hw; f32x4 x = xin[s2];
            if (s2 < 5) {
                float ss = (x[0] * x[0] + x[1] * x[1]) + (x[2] * x[2] + x[3] * x[3]);
                ss = dpp_sum16(ss); ss += __shfl_xor(ss, 16);
                const float rs = rsqrtf(ss * (1.0f / 128.0f) + 1e-6f);
                x = x * rs * (s2 < 4 ? qg : kg);
                if (lat) { f32x4 pt;
#pragma unroll
                    for (int e = 0; e < 4; ++e) pt[e] = __shfl_xor(x[e], 8);
                    x = lowhalf ? x * cs - pt * sn : x * cs + pt * sn; }
            }
            u32x2 xb; xb.x = cvt_pk_bf16(x[0], x[1]); xb.y = cvt_pk_bf16(x[2], x[3]);
            if (s2 < 4) { *(u32x2*)(Qb + (size_t)tok * 1024 + slot * 128 + 4 * j) = xb; }
            else if (s2 == 4) { const int h = hw;
                if (!lat) { *(f32x4*)(p.out + O_CK + ((((size_t)b * 2 + l) * 2 + h) * 256 + t) * 128 + 4 * j) = x;
                            *(u32x2*)(Kc + ((size_t)b * 2 + h) * 256 * 128 + kperm(t, 4 * j)) = xb; }
                else { *(u32x2*)(Kl + ((size_t)b * 2 + h) * 1280 * 128 + kperm(256 + t, 4 * j)) = xb; } }
            else { const int h = hw;
                if (!lat) { *(f32x4*)(p.out + O_CV + ((((size_t)b * 2 + l) * 2 + h) * 256 + t) * 128 + 4 * j) = x;
                            const int kk = t & 31, pp = ((kk & 15) >> 2) * 8 + (kk >> 4) * 4 + (kk & 3);
                            bf16_t* vt = Vtc + ((((size_t)b * 2 + h) * 8 + (t >> 5)) * 128 + 4 * j) * 32 + pp;
                            vt[0] = (bf16_t)(xb.x & 0xffffu); vt[32] = (bf16_t)(xb.x >> 16); vt[64] = (bf16_t)(xb.y & 0xffffu); vt[96] = (bf16_t)(xb.y >> 16); }
                else { const int key = 256 + t, kk = key & 31, pp = ((kk & 15) >> 2) * 8 + (kk >> 4) * 4 + (kk & 3);
                       bf16_t* vt = Vtl + ((((size_t)b * 2 + h) * 40 + (key >> 5)) * 128 + 4 * j) * 32 + pp;
                       vt[0] = (bf16_t)(xb.x & 0xffffu); vt[32] = (bf16_t)(xb.x >> 16); vt[64] = (bf16_t)(xb.y & 0xffffu); vt[96] = (bf16_t)(xb.y >> 16); } }
        }
        const bool hp = t > 0, hn = t < T - 1;
        f32x4 mx[8];
        {
            f32x4 xc[8], xp[8], xn[8];
            const f32x4 z4 = (f32x4){0.f, 0.f, 0.f, 0.f};
#pragma unroll
            for (int it = 0; it < 8; ++it) { const int f = it * 64 + lane; const bool ok = f < 464; const float* q = pr + P_RW + 4 * f;
                xc[it] = ok ? *(const f32x4*)q : z4; xp[it] = (ok && hp) ? *(const f32x4*)(q - PW) : z4; xn[it] = (ok && hn) ? *(const f32x4*)(q + PW) : z4; }
#pragma unroll
            for (int it = 0; it < 8; ++it) { const int f = it * 64 + lane; const f32x4 m4 = (f < 464) ? *(const f32x4*)(mu + 4 * f) : z4; mx[it] = xc[it] + ((xp[it] + xn[it]) * 0.5f - xc[it]) * m4; }
        }
#pragma unroll
        for (int it = 0; it < 8; ++it) { const int f = it * 64 + lane; const int c = 4 * f;
            if (it < 2) { *(f32x4*)(scan + ((size_t)tok * 8 + (c >> 6)) * SB_STRIDE + (c & 63)) = mx[it]; }
            else if (it < 4) { const int cc = c - 512; float* sb = scan + ((size_t)tok * 8 + (cc >> 6)) * SB_STRIDE + (cc & 63);
                *(f32x4*)(sb + 64) = mx[it];
                const f32x4 kx = mx[it] * *(const f32x4*)(xi + cc);
                const float ss = dpp_sum16((kx[0] * kx[0] + kx[1] * kx[1]) + (kx[2] * kx[2] + kx[3] * kx[3]));
                *(f32x4*)(sb + 192) = kx * rsqrtf(ss + 1e-6f); }
            else if (it < 6) { const int cc = c - 1024; *(f32x4*)(scan + ((size_t)tok * 8 + (cc >> 6)) * SB_STRIDE + 128 + (cc & 63)) = mx[it]; }
            else if (f < 464) { const int cc = c - 1536;
                f32x4 v;
#pragma unroll
                for (int e = 0; e < 4; ++e) v[e] = cc < 128 ? (1.0f - 2.0f * frcp(1.0f + __expf(2.0f * mx[it][e]))) : (cc < 192 ? mx[it][e] : sigmoidf_(mx[it][e]));
                u32x2 w; w.x = cvt_pk_bf16(v[0], v[1]); w.y = cvt_pk_bf16(v[2], v[3]); *(u32x2*)(Alr + (size_t)tok * 384 + cc) = w; }
        }
        if (lane < 16) *(u32x2*)(Alr + (size_t)tok * 384 + 320 + lane * 4) = (u32x2){0u, 0u};
    }
}

template <int QT> __device__ __forceinline__ void attn_item(const bf16_t* __restrict__ Q, const bf16_t* __restrict__ K, const bf16_t* __restrict__ Vt, int Tk, bf16_t* __restrict__ O, int lane) {
    const int fr = lane & 15, fq = lane >> 4;
    bf16x8 qf[QT][4];
#pragma unroll
    for (int t = 0; t < QT; ++t)
#pragma unroll
        for (int kc = 0; kc < 4; ++kc) qf[t][kc] = *(const bf16x8*)(Q + (size_t)(t * 16 + fr) * 1024 + kc * 32 + fq * 8);
    f32x4 o[QT][8]; float mrun[QT], lrun[QT];
#pragma unroll
    for (int t = 0; t < QT; ++t) { mrun[t] = -1e30f; lrun[t] = 0.f;
#pragma unroll
        for (int dt = 0; dt < 8; ++dt) o[t][dt] = (f32x4){0.f, 0.f, 0.f, 0.f}; }
    const float scl = 0.08838834764831845f * 1.4426950408889634f;
    bf16x8 kf[2][4];
#pragma unroll
    for (int kt = 0; kt < 2; ++kt)
#pragma unroll
        for (int kc = 0; kc < 4; ++kc) kf[kt][kc] = *(const bf16x8*)(K + ((size_t)(kt * 4 + kc) * 64 + lane) * 8);
    for (int kb = 0; kb < Tk; kb += 32) {
        bf16x8 vfr[8];
#pragma unroll
        for (int dt = 0; dt < 8; ++dt) vfr[dt] = *(const bf16x8*)(Vt + ((size_t)(kb >> 5) * 128 + dt * 16 + fr) * 32 + fq * 8);
        f32x4 s0[QT], s1[QT];
#pragma unroll
        for (int t = 0; t < QT; ++t) { s0[t] = (f32x4){0.f, 0.f, 0.f, 0.f}; s1[t] = (f32x4){0.f, 0.f, 0.f, 0.f};
#pragma unroll
            for (int kc = 0; kc < 4; ++kc) { s0[t] = __builtin_amdgcn_mfma_f32_16x16x32_bf16(kf[0][kc], qf[t][kc], s0[t], 0, 0, 0); s1[t] = __builtin_amdgcn_mfma_f32_16x16x32_bf16(kf[1][kc], qf[t][kc], s1[t], 0, 0, 0); } }
        { const int kbn = (kb + 32 < Tk) ? kb + 32 : kb;
#pragma unroll
          for (int kt = 0; kt < 2; ++kt)
#pragma unroll
            for (int kc = 0; kc < 4; ++kc) kf[kt][kc] = *(const bf16x8*)(K + ((size_t)(((kbn >> 4) + kt) * 4 + kc) * 64 + lane) * 8); }
        bf16x8 pb[QT];
#pragma unroll
        for (int t = 0; t < QT; ++t) {
            f32x4 a0 = s0[t] * scl, a1 = s1[t] * scl;
            float mx = fmaxf(fmaxf(fmaxf(a0[0], a0[1]), fmaxf(a0[2], a0[3])), fmaxf(fmaxf(a1[0], a1[1]), fmaxf(a1[2], a1[3])));
            mx = fmaxf(mx, __shfl_xor(mx, 16)); mx = fmaxf(mx, __shfl_xor(mx, 32));
            const float mnew = (mx > mrun[t] + 8.0f) ? mx : mrun[t];
            if (__builtin_amdgcn_ballot_w64(mnew != mrun[t]) != 0ull) {
                const float alpha = __builtin_amdgcn_exp2f(fmaxf(mrun[t] - mnew, -126.0f)); lrun[t] *= alpha;
#pragma unroll
                for (int dt = 0; dt < 8; ++dt) o[t][dt] *= alpha;
                mrun[t] = mnew;
            }
            float ps = 0.f;
#pragma unroll
            for (int e = 0; e < 4; ++e) { a0[e] = __builtin_amdgcn_exp2f(a0[e] - mnew); a1[e] = __builtin_amdgcn_exp2f(a1[e] - mnew); ps += a0[e] + a1[e]; }
            lrun[t] += ps;
            u32x4 w; w.x = cvt_pk_bf16(a0[0], a0[1]); w.y = cvt_pk_bf16(a0[2], a0[3]); w.z = cvt_pk_bf16(a1[0], a1[1]); w.w = cvt_pk_bf16(a1[2], a1[3]);
            pb[t] = __builtin_bit_cast(bf16x8, w);
        }
#pragma unroll
        for (int dt = 0; dt < 8; ++dt) {
#pragma unroll
            for (int t = 0; t < QT; ++t) o[t][dt] = __builtin_amdgcn_mfma_f32_16x16x32_bf16(vfr[dt], pb[t], o[t][dt], 0, 0, 0);
        }
    }
#pragma unroll
    for (int t = 0; t < QT; ++t) {
        float l = lrun[t]; l += __shfl_xor(l, 16); l += __shfl_xor(l, 32);
        const float li = frcp(l);
#pragma unroll
        for (int dt = 0; dt < 8; ++dt) { const f32x4 v = o[t][dt] * li; u32x2 w; w.x = cvt_pk_bf16(v[0], v[1]); w.y = cvt_pk_bf16(v[2], v[3]);
            *(u32x2*)(O + (size_t)(t * 16 + fr) * 2048 + dt * 16 + fq * 4) = w; }
    }
}
__device__ __forceinline__ void attn_phase(CPR p) {
    const int wid = tid_l() >> 6, lane = tid_l() & 63;
    const bf16_t* Qb = (const bf16_t*)(p.ws + WS_QB); bf16_t* Oa = (bf16_t*)(p.ws + WS_OATT);
    const bf16_t* Kc = (const bf16_t*)(p.ws + WS_KC); const bf16_t* Vtc = (const bf16_t*)(p.ws + WS_VTC); const bf16_t* Kl = (const bf16_t*)(p.ws + WS_KL); const bf16_t* Vtl = (const bf16_t*)(p.ws + WS_VTL);
    for (int i = blockIdx.x * 4 + (wid & 3); i < 1024; i += gridDim.x * 4) {
        if (wid < 4) {
            const int qt = i & 31, hq = (i >> 5) & 7, b = i >> 8, hk = hq >> 2;
            const size_t tok0 = NCTX + (size_t)b * 1024 + qt * 32;
            attn_item<2>(Qb + tok0 * 1024 + hq * 128, Kl + ((size_t)b * 2 + hk) * 1280 * 128, Vtl + ((size_t)b * 2 + hk) * 128 * 1280, 1280, Oa + tok0 * 2048 + hq * 128, lane);
        } else {
            const int qt = i & 7, hq = (i >> 3) & 7, b = i >> 6, hk = hq >> 2;
            const size_t tok0 = (size_t)b * 256 + qt * 32;
            attn_item<2>(Qb + tok0 * 1024 + hq * 128, Kc + ((size_t)b * 2 + hk) * 256 * 128, Vtc + ((size_t)b * 2 + hk) * 128 * 256, 256, Oa + tok0 * 2048 + hq * 128, lane);
        }
    }
}

constexpr int GL_GAD = 0, GL_TOT = 4096, GL_QE = 6144, GL_KE = 23552, GL_KLT = 40960, GL_VT = 59392, GL_OSUM = 77824;
__device__ __forceinline__ float log_sigmoidf_(float z) { return fminf(z, 0.f) - __logf(1.0f + __expf(-fabsf(z))); }
__device__ __forceinline__ f32x4 gla_stage(LAS unsigned char* lds, CPR p, int l, int h, int cg, int dir) {
    const int tid = tid_l(), dq = tid & 31, rg = tid >> 5;
    const float* P = (const float*)(p.ws + WS_P);
    LAS float* gadL = (LAS float*)(lds + GL_GAD); LAS float* tot = (LAS float*)(lds + GL_OSUM);
    LAS bf16_t* qe = (LAS bf16_t*)(lds + GL_QE); LAS bf16_t* ke = (LAS bf16_t*)(lds + GL_KE); LAS bf16_t* klT = (LAS bf16_t*)(lds + GL_KLT); LAS bf16_t* vT = (LAS bf16_t*)(lds + GL_VT);
    const int tbase = cg * 64;
    { const int idx = tid * 2, i = idx >> 4, r = idx & 15; const int tok = dir ? tbase + 63 - i : tbase + i;
      const f32x2 g = *(const f32x2*)(P + (size_t)tok * PW + P_GAD + dir * 16 + r); gadL[idx] = g[0]; gadL[idx + 1] = g[1]; }
    const float* aup = p.in[I_GAUP] + ((size_t)l * 2 + dir) * 16 * 512 + h * 128 + 4 * dq;
    f32x4 au[16];
#pragma unroll
    for (int r = 0; r < 16; ++r) au[r] = *(const f32x4*)(aup + r * 512);
    const f32x4 bias = *(const f32x4*)(p.in[I_GABIAS] + ((size_t)l * 2 + dir) * 512 + h * 128 + 4 * dq);
    f32x4 q4[4], k4[4], v4[4];
#pragma unroll
    for (int k = 0; k < 4; ++k) { const int i = rg * 4 + k; const int tok = dir ? tbase + 63 - i : tbase + i; const float* pr = P + (size_t)tok * PW + h * 128 + 4 * dq;
        q4[k] = *(const f32x4*)(pr + P_GQ); k4[k] = *(const f32x4*)(pr + P_GK); v4[k] = *(const f32x4*)(pr + P_GV); }
    __syncthreads();
    f32x4 cl[4]; f32x4 c = (f32x4){0.f, 0.f, 0.f, 0.f};
#pragma unroll
    for (int k = 0; k < 4; ++k) { const int i = rg * 4 + k; f32x4 z = bias;
#pragma unroll
        for (int r = 0; r < 16; ++r) z += au[r] * gadL[i * 16 + r];
#pragma unroll
        for (int e = 0; e < 4; ++e) c[e] += log_sigmoidf_(z[e]) * (1.0f / 16.0f);
        cl[k] = c; }
    *(LAS f32x4*)(tot + rg * 128 + 4 * dq) = c;
    __syncthreads();
    f32x4 off = (f32x4){0.f, 0.f, 0.f, 0.f}, clast = (f32x4){0.f, 0.f, 0.f, 0.f};
#pragma unroll
    for (int g = 0; g < 16; ++g) { const f32x4 tv = *(const LAS f32x4*)(tot + g * 128 + 4 * dq); clast += tv; if (g < rg) off += tv; }
    f32x4 klr[4], vr[4];
#pragma unroll
    for (int k = 0; k < 4; ++k) { const int i = rg * 4 + k; const f32x4 cm = cl[k] + off; f32x4 qo, ko;
#pragma unroll
        for (int e = 0; e < 4; ++e) { const float E = __expf(cm[e]), iE = __expf(-cm[e]);
            qo[e] = q4[k][e] * 0.08838834764831845f * E; ko[e] = k4[k][e] * iE; klr[k][e] = k4[k][e] * __expf(clast[e] - cm[e]); }
        vr[k] = v4[k];
        u32x2 w; w.x = cvt_pk_bf16(qo[0], qo[1]); w.y = cvt_pk_bf16(qo[2], qo[3]); *(LAS u32x2*)(qe + i * 136 + 4 * dq) = w;
        w.x = cvt_pk_bf16(ko[0], ko[1]); w.y = cvt_pk_bf16(ko[2], ko[3]); *(LAS u32x2*)(ke + i * 136 + 4 * dq) = w; }
#pragma unroll
    for (int e = 0; e < 4; ++e) { u32x2 w;
        w.x = cvt_pk_bf16(klr[0][e], klr[1][e]); w.y = cvt_pk_bf16(klr[2][e], klr[3][e]); *(LAS u32x2*)(klT + (4 * dq + e) * 72 + rg * 4) = w;
        w.x = cvt_pk_bf16(vr[0][e], vr[1][e]); w.y = cvt_pk_bf16(vr[2][e], vr[3][e]); *(LAS u32x2*)(vT + (4 * dq + e) * 72 + rg * 4) = w; }
    __syncthreads();
    f32x4 dec;
#pragma unroll
    for (int e = 0; e < 4; ++e) dec[e] = __expf(clast[e]);
    return dec;
}
__device__ __forceinline__ void gla_g1(LAS unsigned char* lds, CPR p, int l) {
    const int tid = tid_l(), wid = tid >> 6, lane = tid & 63, fr = lane & 15, fq = lane >> 4;
    float* KVt = (float*)(p.ws + WS_KVT); float* DEC = (float*)(p.ws + WS_DEC);
    LAS bf16_t* klT = (LAS bf16_t*)(lds + GL_KLT); LAS bf16_t* vT = (LAS bf16_t*)(lds + GL_VT);
    for (int item = blockIdx.x; item < 1024; item += gridDim.x) {
        const int cg = item & 127, h = (item >> 7) & 3, dir = item >> 9;
        const f32x4 dec = gla_stage(lds, p, l, h, cg, dir);
        const size_t ib = ((size_t)dir * 4 + h) * 128 + cg;
        if (tid < 32) *(f32x4*)(DEC + ib * 128 + 4 * tid) = dec;
        { bf16_t* gst = (bf16_t*)(p.ws + WS_GST) + ib * 24576;
#pragma unroll
          for (int r = 0; r < 6; ++r) { const int c = tid + 512 * r; const int sect = c >> 10, cc = c & 1023;
              const LAS bf16_t* src = sect == 0 ? (LAS bf16_t*)(lds + GL_QE) + (cc >> 4) * 136 + (cc & 15) * 8 : (sect == 1 ? (LAS bf16_t*)(lds + GL_KE) + (cc >> 4) * 136 + (cc & 15) * 8 : (LAS bf16_t*)(lds + GL_VT) + (cc >> 3) * 72 + (cc & 7) * 8);
              *(u32x4*)(gst + (size_t)c * 8) = *(const LAS u32x4*)src; } }
        const int v0 = wid * 16;
        const bf16x8 a0 = *(const LAS bf16x8*)(vT + (v0 + fr) * 72 + fq * 8), a1 = *(const LAS bf16x8*)(vT + (v0 + fr) * 72 + 32 + fq * 8);
#pragma unroll
        for (int dt = 0; dt < 8; ++dt) {
            const bf16x8 b0 = *(const LAS bf16x8*)(klT + (dt * 16 + fr) * 72 + fq * 8), b1 = *(const LAS bf16x8*)(klT + (dt * 16 + fr) * 72 + 32 + fq * 8);
            f32x4 acc = (f32x4){0.f, 0.f, 0.f, 0.f};
            acc = __builtin_amdgcn_mfma_f32_16x16x32_bf16(b0, a0, acc, 0, 0, 0); acc = __builtin_amdgcn_mfma_f32_16x16x32_bf16(b1, a1, acc, 0, 0, 0);
            *(f32x4*)(KVt + (ib * 128 + v0 + fr) * 128 + dt * 16 + fq * 4) = acc;
        }
        __syncthreads();
    }
}
__device__ __forceinline__ void gla_g2(CPR p, int l, int gtid, int gthreads) {
    const float* KVt = (const float*)(p.ws + WS_KVT); const float* DEC = (const float*)(p.ws + WS_DEC); bf16_t* SSt = (bf16_t*)(p.ws + WS_SST);
    for (int idx = gtid; idx < 160 * 4096; idx += gthreads) {
        const int d4 = idx & 31, v = (idx >> 5) & 127, sc = idx >> 12;
        const int seq = sc % 20, dh = sc / 20, h = dh & 3, dir = dh >> 2;
        const bool lat = seq >= 16; const int N = lat ? 16 : 4, cg0 = lat ? 64 + (seq - 16) * 16 : seq * 4, b = lat ? seq - 16 : seq;
        f32x4 S = (f32x4){0.f, 0.f, 0.f, 0.f};
        if (lat) { const float* s0 = p.in[I_SG] + (((((size_t)b * 2 + l) * 2 + dir) * 4 + h) * 128 + d4 * 4) * 128 + v;
#pragma unroll
            for (int e = 0; e < 4; ++e) S[e] = s0[e * 128]; }
        for (int m = 0; m < N; ++m) {
            const int cg = dir ? cg0 + N - 1 - m : cg0 + m; const size_t ib = (size_t)dh * 128 + cg;
            u32x2 w; w.x = cvt_pk_bf16(S[0], S[1]); w.y = cvt_pk_bf16(S[2], S[3]);
            *(u32x2*)(SSt + (ib * 128 + v) * 128 + d4 * 4) = w;
            const f32x4 dec = *(const f32x4*)(DEC + ib * 128 + d4 * 4), kv = *(const f32x4*)(KVt + (ib * 128 + v) * 128 + d4 * 4);
            S = dec * S + kv;
        }
        if (!lat) { float* o = p.out + O_SG + (((((size_t)b * 2 + l) * 2 + dir) * 4 + h) * 128 + d4 * 4) * 128 + v;
#pragma unroll
            for (int e = 0; e < 4; ++e) o[e * 128] = S[e]; }
    }
}
__device__ __forceinline__ void gla_g3(LAS unsigned char* lds, CPR p, int l) {
    const int tid = tid_l(), wid = tid >> 6, lane = tid & 63, fr = lane & 15, fq = lane >> 4;
    const int it = wid & 3, vh = wid >> 2;
    const float* P = (const float*)(p.ws + WS_P); const bf16_t* SSt = (const bf16_t*)(p.ws + WS_SST); bf16_t* Og = (bf16_t*)(p.ws + WS_OATT) + 1024;
    LAS bf16_t* qe = (LAS bf16_t*)(lds + GL_QE); LAS bf16_t* ke = (LAS bf16_t*)(lds + GL_KE); LAS bf16_t* vT = (LAS bf16_t*)(lds + GL_VT); LAS float* osum = (LAS float*)(lds + GL_OSUM);
    const float* gn = p.in[I_GNORM] + l * 128;
    float one = 1.0f; asm volatile("" : "+v"(one));
    for (int item = blockIdx.x; item < 512; item += gridDim.x) {
        const int cg = item & 127, h = item >> 7;
#pragma unroll 1
        for (int dir = 0; dir < 2; ++dir) {
            bf16x8 sreg[4][4];
            { const bf16_t* ss0 = SSt + (((size_t)dir * 4 + h) * 128 + cg) * 16384;
#pragma unroll
              for (int vt = 0; vt < 4; ++vt)
#pragma unroll
                for (int kc = 0; kc < 4; ++kc) sreg[vt][kc] = __builtin_nontemporal_load((const bf16x8*)(ss0 + (size_t)((vh * 4 + vt) * 16 + fr) * 128 + kc * 32 + fq * 8)); }
            { const bf16_t* gst = (const bf16_t*)(p.ws + WS_GST) + (((size_t)dir * 4 + h) * 128 + cg) * 24576;
              u32x4 tmp[6];
#pragma unroll
              for (int r = 0; r < 6; ++r) tmp[r] = __builtin_nontemporal_load((const u32x4*)(gst + (size_t)(tid + 512 * r) * 8));
#pragma unroll
              for (int r = 0; r < 6; ++r) { const int c = tid + 512 * r; const int sect = c >> 10, cc = c & 1023;
                  LAS bf16_t* dst = sect == 0 ? (LAS bf16_t*)(lds + GL_QE) + (cc >> 4) * 136 + (cc & 15) * 8 : (sect == 1 ? (LAS bf16_t*)(lds + GL_KE) + (cc >> 4) * 136 + (cc & 15) * 8 : (LAS bf16_t*)(lds + GL_VT) + (cc >> 3) * 72 + (cc & 7) * 8);
                  *(LAS u32x4*)dst = tmp[r]; }
              __syncthreads(); }
            bf16x8 qf[4];
#pragma unroll
            for (int kc = 0; kc < 4; ++kc) qf[kc] = *(const LAS bf16x8*)(qe + (it * 16 + fr) * 136 + kc * 32 + fq * 8);
            f32x4 o[4];
#pragma unroll
            for (int vt = 0; vt < 4; ++vt) o[vt] = (f32x4){0.f, 0.f, 0.f, 0.f};
            const bf16_t* ss = SSt + (((size_t)dir * 4 + h) * 128 + cg) * 16384;
#pragma unroll
            for (int vt = 0; vt < 4; ++vt) { const int v0 = (vh * 4 + vt) * 16;
#pragma unroll
                for (int kc = 0; kc < 4; ++kc) o[vt] = __builtin_amdgcn_mfma_f32_16x16x32_bf16(sreg[vt][kc], qf[kc], o[vt], 0, 0, 0); }
#pragma unroll
            for (int jp = 0; jp < 2; ++jp) {
                if (2 * jp <= it) {
                    f32x4 s[2];
#pragma unroll
                    for (int e = 0; e < 2; ++e) { const int jt = 2 * jp + e; s[e] = (f32x4){0.f, 0.f, 0.f, 0.f};
                        if (jt <= it) {
#pragma unroll
                            for (int kc = 0; kc < 4; ++kc) { const bf16x8 ka = *(const LAS bf16x8*)(ke + (jt * 16 + fr) * 136 + kc * 32 + fq * 8);
                                s[e] = __builtin_amdgcn_mfma_f32_16x16x32_bf16(ka, qf[kc], s[e], 0, 0, 0); }
                            if (jt == it) {
#pragma unroll
                                for (int j = 0; j < 4; ++j) if (fq * 4 + j > fr) s[e][j] = 0.f; }
                        } }
                    s[0] *= one; s[1] *= one;
                    u32x4 w; w.x = cvt_pk_bf16(s[0][0], s[0][1]); w.y = cvt_pk_bf16(s[0][2], s[0][3]); w.z = cvt_pk_bf16(s[1][0], s[1][1]); w.w = cvt_pk_bf16(s[1][2], s[1][3]);
                    const bf16x8 pb = __builtin_bit_cast(bf16x8, w);
#pragma unroll
                    for (int vt = 0; vt < 4; ++vt) { const int v0 = (vh * 4 + vt) * 16;
                        const LAS bf16_t* vp = vT + (v0 + fr) * 72 + jp * 32 + fq * 4;
                        const u32x2 va = *(const LAS u32x2*)vp, vb = *(const LAS u32x2*)(vp + 16);
                        u32x4 vw; vw.x = va.x; vw.y = va.y; vw.z = vb.x; vw.w = vb.y;
                        o[vt] = __builtin_amdgcn_mfma_f32_16x16x32_bf16(__builtin_bit_cast(bf16x8, vw), pb, o[vt], 0, 0, 0); }
                }
            }
            const int i = it * 16 + fr, tl = dir ? 63 - i : i;
#pragma unroll
            for (int vt = 0; vt < 4; ++vt) { LAS f32x4* op = (LAS f32x4*)(osum + tl * 132 + (vh * 4 + vt) * 16 + fq * 4);
                if (dir == 0) *op = o[vt]; else *op = *op + o[vt]; }
            __syncthreads();
        }
        { const int hw = lane >> 5, j = lane & 31; const f32x4 g4 = *(const f32x4*)(gn + 4 * j);
#pragma unroll
          for (int r = 0; r < 4; ++r) { const int tl = wid * 8 + r * 2 + hw, tok = cg * 64 + tl;
            const f32x4 x = *(const LAS f32x4*)(osum + tl * 132 + 4 * j);
            float ssq = (x[0] * x[0] + x[1] * x[1]) + (x[2] * x[2] + x[3] * x[3]);
            ssq = dpp_sum16(ssq); ssq += __shfl_xor(ssq, 16);
            const float rs = rsqrtf(ssq * (1.0f / 128.0f) + 1e-6f);
            const f32x4 gg = *(const f32x4*)(P + (size_t)tok * PW + P_GG + h * 128 + 4 * j);
            f32x4 o;
#pragma unroll
            for (int e = 0; e < 4; ++e) o[e] = x[e] * rs * g4[e] * siluf_(gg[e]);
            u32x2 w; w.x = cvt_pk_bf16(o[0], o[1]); w.y = cvt_pk_bf16(o[2], o[3]);
            *(u32x2*)(Og + (size_t)tok * 2048 + h * 128 + 4 * j) = w; } }
        __syncthreads();
    }
}

__device__ __forceinline__ float dpp_sum8(float x) {
    int xi = __builtin_bit_cast(int, x);
    x += __builtin_bit_cast(float, __builtin_amdgcn_update_dpp(0, xi, 0xB1, 0xf, 0xf, true));
    xi = __builtin_bit_cast(int, x);
    x += __builtin_bit_cast(float, __builtin_amdgcn_update_dpp(0, xi, 0x4E, 0xf, 0xf, true));
    xi = __builtin_bit_cast(int, x);
    x += __builtin_bit_cast(float, __builtin_amdgcn_update_dpp(0, xi, 0x141, 0xf, 0xf, true));
    return x;
}
__device__ __forceinline__ void rwkv_scan_job(LAS unsigned char* lds, CPR p, int l, int job) {
    const int tid = tid_l(), wid = tid >> 6, lane = tid & 63, kp = lane & 7;
    const bool lat = job < 128; const int jj = lat ? job : job - 128;
    const int half = jj & 1, dir = (jj >> 1) & 1, h = (jj >> 2) & 7, b = jj >> 5;
    const int T = lat ? 1024 : 256, tok0 = lat ? NCTX + b * 1024 : b * 256;
    const float* __restrict__ scan = (const float*)(p.ws + WS_SCAN);
    float* __restrict__ yout = (float*)(p.ws + (dir ? WS_YB : WS_YF));
    LAS float* buf = (LAS float*)lds;
    const int nch = T / 32;
    const int woff = dir ? 384 : 320;
    if (wid >= 4) {
        const int lt = tid - 256;
        f32x4 A[14], B[14];
#define SC_GLOAD(R, c_) do { _Pragma("unroll") for (int r = 0; r < 14; ++r) { const int idx = lt + 256 * r; const int ss = idx / 112, e = idx - ss * 112; const int st = (c_) * 32 + ss; \
            const int tok = dir ? tok0 + T - 1 - st : tok0 + st; R[r] = *(const f32x4*)(scan + ((size_t)tok * 8 + h) * SB_STRIDE + e * 4); } } while (0)
#define SC_LSTORE(R, c_) do { _Pragma("unroll") for (int r = 0; r < 14; ++r) { const int idx = lt + 256 * r; *(LAS f32x4*)(buf + ((c_) & 1) * 14336 + idx * 4) = R[r]; } } while (0)
#define SC_STEP(c_, Rl, Rs) do { if ((c_) + 2 < nch) SC_GLOAD(Rl, (c_) + 2); if ((c_) + 1 < nch) SC_LSTORE(Rs, (c_) + 1); __syncthreads(); } while (0)
        SC_GLOAD(A, 0); SC_GLOAD(B, 1);
        SC_LSTORE(A, 0);
        __syncthreads();
        for (int c = 0; c < nch; c += 2) {
            SC_STEP(c, A, B);
            if (c + 1 < nch) SC_STEP(c + 1, B, A);
        }
#undef SC_GLOAD
#undef SC_LSTORE
#undef SC_STEP
    } else {
        const int v = half * 32 + wid * 8 + (lane >> 3);
        f32x4 s0 = (f32x4){0.f, 0.f, 0.f, 0.f}, s1 = (f32x4){0.f, 0.f, 0.f, 0.f};
        if (lat) { const float* sp = p.in[I_SR] + ((((((size_t)b * 2 + l) * 2 + dir) * 8 + h) * 64 + v) * 64) + kp * 8; s0 = *(const f32x4*)sp; s1 = *(const f32x4*)(sp + 4); }
        __syncthreads();
        __builtin_amdgcn_s_setprio(3);
        for (int c = 0; c < nch; ++c) {
          for (int hb = 0; hb < 2; ++hb) {
            const LAS float* bb = buf + (c & 1) * 14336 + hb * 7168;
            float ykeep = 0.f;
            f32x4 nr0, nr1, nk0, nk1, nkap0, nkap1, nka0, nka1, nw0, nw1; float nvv;
#define SC_LD(ss_) do { const LAS float* row = bb + (ss_) * 448 + kp * 8; nr0 = *(const LAS f32x4*)(row); nr1 = *(const LAS f32x4*)(row + 4); nk0 = *(const LAS f32x4*)(row + 64); nk1 = *(const LAS f32x4*)(row + 68); \
                nkap0 = *(const LAS f32x4*)(row + 192); nkap1 = *(const LAS f32x4*)(row + 196); nka0 = *(const LAS f32x4*)(row + 256); nka1 = *(const LAS f32x4*)(row + 260); \
                nw0 = *(const LAS f32x4*)(row + woff); nw1 = *(const LAS f32x4*)(row + woff + 4); nvv = bb[(ss_) * 448 + 128 + v]; } while (0)
            SC_LD(0);
#pragma unroll
            for (int ss = 0; ss < 16; ++ss) {
                const f32x4 r0 = nr0, r1 = nr1, k0 = nk0, k1 = nk1, kap0 = nkap0, kap1 = nkap1, ka0 = nka0, ka1 = nka1, w0 = nw0, w1 = nw1; const float vv = nvv;
                if (ss < 15) SC_LD(ss + 1);
                __builtin_amdgcn_sched_barrier(0);
                const f32x4 t0 = s0 * kap0 + s1 * kap1;
                const float sk = dpp_sum8((t0[0] + t0[1]) + (t0[2] + t0[3]));
                s0 = s0 * w0 + (k0 * vv - ka0 * sk); s1 = s1 * w1 + (k1 * vv - ka1 * sk);
                const f32x4 t1 = s0 * r0 + s1 * r1;
                const float y = dpp_sum8((t1[0] + t1[1]) + (t1[2] + t1[3]));
                ykeep = (kp == (ss & 7)) ? y : ykeep;
                if ((ss & 7) == 7) { const int st = c * 32 + hb * 16 + (ss & 8) + kp; const int tok = dir ? tok0 + T - 1 - st : tok0 + st; yout[(size_t)tok * 512 + h * 64 + v] = ykeep; }
            }
#undef SC_LD
          }
            __syncthreads();
        }
        __builtin_amdgcn_s_setprio(0);
        if (!lat) { float* sp = p.out + O_SR + ((((((size_t)b * 2 + l) * 2 + dir) * 8 + h) * 64 + v) * 64) + kp * 8; *(f32x4*)sp = s0; *(f32x4*)(sp + 4) = s1; }
    }
}
__device__ __forceinline__ void rwkv_scan_phase(LAS unsigned char* lds, CPR p, int l) {
    const int wg = blockIdx.x, nwg = gridDim.x;
    for (int j = 0; j < 640; ++j) {
        const int owner = (j < 128) ? (j % nwg) : (nwg > 128 ? 128 + (j - 128) % (nwg - 128) : j % nwg);
        if (owner == wg) rwkv_scan_job(lds, p, l, j);
    }
}
__device__ __forceinline__ void rwkv_post(CPR p, int l, int gwave, int nwave) {
    const int lane = tid_l() & 63;
    const float* __restrict__ scan = (const float*)(p.ws + WS_SCAN); const float* __restrict__ yf = (const float*)(p.ws + WS_YF); const float* __restrict__ yb = (const float*)(p.ws + WS_YB); const float* __restrict__ gout = (const float*)(p.ws + WS_GOUT);
    bf16_t* __restrict__ Y = (bf16_t*)(p.ws + WS_OATT) + 1536;
    const float* rho = p.in[I_RBONUS] + l * 512; const float* lw = p.in[I_RLNW] + l * 512; const float* lb = p.in[I_RLNB] + l * 512;
    f32x4 rh[2], w4[2], b4[2];
#pragma unroll
    for (int it = 0; it < 2; ++it) { const int c = 4 * (it * 64 + lane); rh[it] = *(const f32x4*)(rho + c); w4[it] = *(const f32x4*)(lw + c); b4[it] = *(const f32x4*)(lb + c); }
    for (int tok = gwave; tok < NTOK; tok += nwave) {
        f32x4 r[2], kk[2], vv[2], ys[2], go[2];
#pragma unroll
        for (int it = 0; it < 2; ++it) { const int c = 4 * (it * 64 + lane); const float* sb = scan + ((size_t)tok * 8 + (c >> 6)) * SB_STRIDE + (c & 63);
            r[it] = *(const f32x4*)sb; kk[it] = *(const f32x4*)(sb + 64); vv[it] = *(const f32x4*)(sb + 128);
            ys[it] = *(const f32x4*)(yf + (size_t)tok * 512 + c) + *(const f32x4*)(yb + (size_t)tok * 512 + c); go[it] = *(const f32x4*)(gout + (size_t)tok * 512 + c); }
#pragma unroll
        for (int it = 0; it < 2; ++it) { const int c = 4 * (it * 64 + lane);
            const f32x4 t = r[it] * kk[it] * rh[it];
            const float bs = dpp_sum16((t[0] + t[1]) + (t[2] + t[3]));
            const f32x4 y = ys[it] + vv[it] * bs;
            const float mean = dpp_sum16((y[0] + y[1]) + (y[2] + y[3])) * (1.0f / 64.0f); const f32x4 xc = y - mean;
            const float var = dpp_sum16((xc[0] * xc[0] + xc[1] * xc[1]) + (xc[2] * xc[2] + xc[3] * xc[3])) * (1.0f / 64.0f);
            const f32x4 o = (xc * rsqrtf(var + 64e-5f) * w4[it] + b4[it]) * go[it];
            u32x2 w; w.x = cvt_pk_bf16(o[0], o[1]); w.y = cvt_pk_bf16(o[2], o[3]);
            *(u32x2*)(Y + (size_t)tok * 2048 + c) = w; }
    }
}

__device__ __forceinline__ void conv_act_phase(CPR p, int l, int gtid, int gthreads) {
    const bf16_t* __restrict__ U = (const bf16_t*)(p.ws + WS_U); bf16_t* __restrict__ A = (bf16_t*)(p.ws + WS_ABF);
    const float* cw = p.in[I_FCW] + (size_t)l * 3 * FU; const float* cb = p.in[I_FCB] + (size_t)l * FU;
    for (int item = gtid; item < 256 * 688; item += gthreads) {
        const int vc = item % 688, tb = item / 688; const int c0 = vc * 8, t0 = tb * 32;
        float wv[3][8], wg[3][8], bv[8], bg[8];
#pragma unroll
        for (int e = 0; e < 8; ++e) { bv[e] = cb[c0 + e]; bg[e] = cb[FH + c0 + e];
#pragma unroll
            for (int k = 0; k < 3; ++k) { wv[k][e] = cw[k * FU + c0 + e]; wg[k][e] = cw[k * FU + FH + c0 + e]; } }
        const int T = t0 < NCTX ? 256 : 1024; const int tin = t0 < NCTX ? (t0 & 255) : ((t0 - NCTX) & 1023);
        u32x4 pv, pg, cv, cgv, nv, ng; const u32x4 z = (u32x4){0u, 0u, 0u, 0u};
        pv = tin > 0 ? __builtin_nontemporal_load((const u32x4*)(U + (size_t)(t0 - 1) * FU + c0)) : z; pg = tin > 0 ? __builtin_nontemporal_load((const u32x4*)(U + (size_t)(t0 - 1) * FU + FH + c0)) : z;
        cv = __builtin_nontemporal_load((const u32x4*)(U + (size_t)t0 * FU + c0)); cgv = __builtin_nontemporal_load((const u32x4*)(U + (size_t)t0 * FU + FH + c0));
#pragma unroll 1
        for (int i4 = 0; i4 < 32; i4 += 4) {
            u32x4 nv4[4], ng4[4];
#pragma unroll
            for (int q = 0; q < 4; ++q) { const int i = i4 + q; const int t = t0 + i; const bool hn = (tin + i) < T - 1;
                nv4[q] = hn ? __builtin_nontemporal_load((const u32x4*)(U + (size_t)(t + 1) * FU + c0)) : z; ng4[q] = hn ? __builtin_nontemporal_load((const u32x4*)(U + (size_t)(t + 1) * FU + FH + c0)) : z; }
#pragma unroll
            for (int q = 0; q < 4; ++q) { const int t = t0 + i4 + q; nv = nv4[q]; ng = ng4[q];
                float ov[8];
#pragma unroll
                for (int e = 0; e < 8; ++e) { const int wi = e >> 1; const bool hi = e & 1;
                    auto ex = [&](const u32x4& qq) { const unsigned w = qq[wi]; return __uint_as_float(hi ? (w & 0xffff0000u) : (w << 16)); };
                    const float val = wv[0][e] * ex(pv) + wv[1][e] * ex(cv) + wv[2][e] * ex(nv) + bv[e];
                    const float gat = wg[0][e] * ex(pg) + wg[1][e] * ex(cgv) + wg[2][e] * ex(ng) + bg[e];
                    ov[e] = siluf_(gat) * val; }
                u32x4 w; w.x = cvt_pk_bf16(ov[0], ov[1]); w.y = cvt_pk_bf16(ov[2], ov[3]); w.z = cvt_pk_bf16(ov[4], ov[5]); w.w = cvt_pk_bf16(ov[6], ov[7]);
                *(u32x4*)(A + (size_t)t * FH + c0) = w;
                pv = cv; pg = cgv; cv = nv; cgv = ng; }
        }
    }
}

#define XB_TMO      128
#define XB_XCNT(j)  (256  + 64 * (j))
#define XB_XSUB(j)  (1280 + 64 * (j))
#define XB_XGEN(j)  (2304 + 64 * (j))
#define XB_TOP      3328
#define XB_TOPGEN   3392
#define XCD_BAR_WORDS 3456
#define XB_SPIN_CAP (1u << 22)
__device__ __forceinline__ unsigned xb_ld(unsigned* p)              { return __hip_atomic_load(p, __ATOMIC_RELAXED, __HIP_MEMORY_SCOPE_AGENT); }
__device__ __forceinline__ unsigned xb_add(unsigned* p, unsigned v) { return __hip_atomic_fetch_add(p, v, __ATOMIC_RELAXED, __HIP_MEMORY_SCOPE_AGENT); }
__device__ __forceinline__ unsigned xb_xcc_id() { return (unsigned)__builtin_amdgcn_s_getreg((3 << 11) | 20) & 0xFu; }
#define XB_SPIN(cond, bar) do { unsigned _sp = 0; while (cond) { __builtin_amdgcn_s_sleep(1); \
    if ((++_sp & 255u) == 0u) { if (xb_ld(&(bar)[XB_TMO])) break; if (_sp > XB_SPIN_CAP) { atomicAdd(&(bar)[XB_TMO], 1u); break; } } } } while (0)
struct XcdBarrier { unsigned* bar; unsigned x; volatile LAS unsigned* st; };
__device__ __forceinline__ void xcd_barrier_post(unsigned* bar) { if (threadIdx.x == 0) (void)xb_add(&bar[XB_XCNT(xb_xcc_id())], 1u); }
__device__ __forceinline__ void xcd_barrier_complete(unsigned* bar, unsigned x, unsigned& nloc, unsigned& nx) {
    const unsigned G = gridDim.x * gridDim.y * gridDim.z;
    unsigned sum, cnt, mine, sp = 0u;
    for (;;) {
        sum = 0u; cnt = 0u; mine = 0u;
#pragma unroll
        for (unsigned j = 0; j < 16; ++j) { const unsigned c = xb_ld(&bar[XB_XCNT(j)]); sum += c; cnt += (c > 0u) ? 1u : 0u; mine = (j == x) ? c : mine; }
        if (sum == G) break;
        __builtin_amdgcn_s_sleep(1);
        if ((++sp & 255u) == 0u) { if (xb_ld(&bar[XB_TMO])) break; if (sp > XB_SPIN_CAP) { atomicAdd(&bar[XB_TMO], 1u); break; } }
    }
    nloc = mine > 0u ? mine : 1u; nx = cnt > 0u ? cnt : 1u;
}
__device__ __forceinline__ void xcd_barrier(const XcdBarrier& b) {
    asm volatile("s_waitcnt vmcnt(0)" ::: "memory");
    __syncthreads();
    if (threadIdx.x == 0) {
        unsigned* bar = b.bar;
        __builtin_amdgcn_s_waitcnt(0);
        unsigned nloc = b.st[0], nx = b.st[1];
        if (nloc == 0u) { xcd_barrier_complete(bar, b.x, nloc, nx); b.st[0] = nloc; b.st[1] = nx; }
        const unsigned old = xb_add(&bar[XB_XSUB(b.x)], 1u);
        const unsigned gen = old / nloc;
        if (old + 1u == (gen + 1u) * nloc) {
            __builtin_amdgcn_fence(__ATOMIC_RELEASE, "agent");
            asm volatile("s_waitcnt vmcnt(0)" ::: "memory");
            const unsigned og = xb_add(&bar[XB_TOP], 1u);
            const unsigned tg = og / nx;
            if (og + 1u == (tg + 1u) * nx) xb_add(&bar[XB_TOPGEN], 1u);
            else XB_SPIN(xb_ld(&bar[XB_TOPGEN]) == tg, bar);
            __builtin_amdgcn_fence(__ATOMIC_ACQUIRE, "agent");
            xb_add(&bar[XB_XGEN(b.x)], 1u);
            asm volatile("s_waitcnt vmcnt(0)" ::: "memory");
        } else {
            XB_SPIN(xb_ld(&bar[XB_XGEN(b.x)]) == gen, bar);
            __builtin_amdgcn_fence(__ATOMIC_ACQUIRE, "agent");
            asm volatile("s_waitcnt vmcnt(0)" ::: "memory");
        }
    }
    __syncthreads();
}

__device__ __forceinline__ void tail_wgs(int nunits, int& tw, int& tn) {
    const int G = (int)gridDim.x, c = (int)blockIdx.x, rem = nunits % G;
    if (rem == 0) { tw = c; tn = G; } else { tn = G - rem; tw = (c >= rem) ? c - rem : -1; }
}
#ifndef PH_MASK
#define PH_MASK 0xFFFFFFFFu
#endif
#define PH(b) if (PH_MASK & (1u << (b)))
__device__ __forceinline__ CPR PPf() { const __attribute__((address_space(4))) Params* q = (const __attribute__((address_space(4))) Params*)__builtin_amdgcn_kernarg_segment_ptr(); asm volatile("" : "+s"(q)); return *q; }
#define PP PPf()
__global__ void __launch_bounds__(512, 2) fwd_megakernel(Params p_unused) {
    extern __shared__ __attribute__((aligned(16))) unsigned char shm[];
    LAS unsigned char* lds = (LAS unsigned char*)shm;
    cg::grid_group grid = cg::this_grid();
#define WGI ((int)blockIdx.x)
#define NWG ((int)gridDim.x)
#define GTID ((int)(blockIdx.x * 512 + tid_l()))
#define GTHREADS ((int)(gridDim.x * 512))
#define GWAVE ((int)(blockIdx.x * 8 + (tid_l() >> 6)))
#define NWAVE ((int)(gridDim.x * 8))
    { unsigned* bar = (unsigned*)(PP.ws + WS_BAR); if (blockIdx.x == 0) for (int i = threadIdx.x; i < XCD_BAR_WORDS; i += 512) bar[i] = 0u;
      if (threadIdx.x < 4) ((volatile LAS unsigned*)(lds + LDS_BYTES - 16))[threadIdx.x] = 0u; }
#define GSYNC() do { XcdBarrier xb_; xb_.bar = (unsigned*)(PP.ws + WS_BAR); xb_.x = xb_xcc_id(); xb_.st = (volatile LAS unsigned*)(lds + LDS_BYTES - 16); xcd_barrier(xb_); } while (0)
    PH(0) mod_phase(PP, (LAS float*)lds, WGI, NWG);
#pragma unroll 1
    for (int l = 0; l < 2; ++l) {
        PH(1) { CPR p = PP; bf16_t* W = (bf16_t*)(p.ws + WS_W);
            convert_job((LAS float*)lds, p.in[I_WIN] + (size_t)l * 2048 * 11616, (bf16_t*)((char*)W + W_IN), 2048, 11616, NIN_PAD, 1, WGI, NWG);
            convert_job((LAS float*)lds, p.in[I_WBRA] + (size_t)l * 1024 * 2048, (bf16_t*)((char*)W + W_BRA), 1024, 2048, 2048, 0, (WGI + 64) % NWG, NWG, 2048);
            convert_job((LAS float*)lds, p.in[I_WBRG] + (size_t)l * 512 * 2048, (bf16_t*)((char*)W + W_BRA) + 1024, 512, 2048, 2048, 0, (WGI + 128) % NWG, NWG, 2048);
            convert_job((LAS float*)lds, p.in[I_WBRR] + (size_t)l * 512 * 2048, (bf16_t*)((char*)W + W_BRA) + 1536, 512, 2048, 2048, 0, (WGI + 192) % NWG, NWG, 2048);
            convert_job((LAS float*)lds, p.in[I_WOUT] + (size_t)l * 2048 * 2048, (bf16_t*)((char*)W + W_OUT), 2048, 2048, 2048, 0, WGI, NWG);
            convert_lr(p, l, (bf16_t*)((char*)W + W_LR), GTID, GTHREADS); }
        if (l == 0) { grid.sync(); xcd_barrier_post((unsigned*)(PP.ws + WS_BAR)); }
        PH(2) { CPR p = PP; norm_phase(p, l, l == 0, p.in[I_NMIX] + l * DM, 0, 1, GWAVE, NWAVE); }
        GSYNC();
        PH(3) { CPR p = PP; EpiIn E; E.P = (float*)(p.ws + WS_P); E.G = (bf16_t*)(p.ws + WS_G); run_gemm(lds, (const bf16_t*)(p.ws + WS_H), (const bf16_t*)(p.ws + WS_W + W_IN), NIN_PAD, 2048, E); }
        GSYNC();
        PH(4) prep_phase(PP, l, GWAVE, NWAVE);
        GSYNC();
        PH(5) attn_phase(PP);
        PH(6) gla_g1(lds, PP, l);
        PH(7) { CPR p = PP; EpiLr E; E.scan = (float*)(p.ws + WS_SCAN); E.gout = (float*)(p.ws + WS_GOUT); E.w0 = p.in[I_RW0] + l * 1024; E.a0 = p.in[I_RA0] + l * 512; E.alpha = p.in[I_RALPHA] + l * 512;
          run_gemm(lds, (const bf16_t*)(p.ws + WS_ALR), (const bf16_t*)(p.ws + WS_W + W_LR), 2048, 384, E); }
        GSYNC();
        PH(8) gla_g2(PP, l, GTID, GTHREADS);
        PH(9) rwkv_scan_phase(lds, PP, l);
        GSYNC();
        PH(10) gla_g3(lds, PP, l);
        PH(11) rwkv_post(PP, l, GWAVE, NWAVE);
        GSYNC();
        PH(12) { CPR p = PP; EpiBrF E; E.merged = (bf16_t*)(p.ws + WS_MERGED); E.G = (const bf16_t*)(p.ws + WS_G);
          run_gemm(lds, (const bf16_t*)(p.ws + WS_OATT), (const bf16_t*)(p.ws + WS_W + W_BRA), 2048, 2048, E); }
        GSYNC();
        PH(13) { CPR p = PP; EpiRes E; E.x = p.out + O_X; E.gate = (const float*)(p.ws + WS_MOD) + (size_t)l * 5 * 12288 + 2 * 2048; E.xin0 = (l == 0) ? p.in[I_XP] : nullptr; E.xin1 = p.in[I_XS];
          run_gemm(lds, (const bf16_t*)(p.ws + WS_MERGED), (const bf16_t*)(p.ws + WS_W + W_OUT), 2048, 2048, E); }
        GSYNC();
        PH(16) { CPR p = PP; bf16_t* W = (bf16_t*)(p.ws + WS_W);
            convert_job((LAS float*)lds, p.in[I_FUP] + (size_t)l * 2048 * FU, (bf16_t*)((char*)W + W_UP), 2048, FU, FU, 0, WGI, NWG);
 }
        PH(17) { CPR p = PP; norm_phase(p, l, false, p.in[I_NFFN] + l * DM, 3, 4, GWAVE, NWAVE); }
        GSYNC();
        PH(15) { CPR p = PP; EpiUp E; E.U = (bf16_t*)(p.ws + WS_U); run_gemm(lds, (const bf16_t*)(p.ws + WS_H), (const bf16_t*)(p.ws + WS_W + W_UP), FU, 2048, E); }
        PH(16) { CPR p = PP; bf16_t* W = (bf16_t*)(p.ws + WS_W); int tw, tn; tail_wgs(32 * (FU / 256), tw, tn);
            if (tw >= 0) convert_job((LAS float*)lds, p.in[I_FDOWN] + (size_t)l * FH * 2048, (bf16_t*)((char*)W + W_DOWN), FH, 2048, 2048, 0, tw, tn); }
        GSYNC();
        PH(14) conv_act_phase(PP, l, GTID, GTHREADS);
        GSYNC();
        PH(18) { CPR p = PP; EpiRes E; E.x = p.out + O_X; E.gate = (const float*)(p.ws + WS_MOD) + (size_t)l * 5 * 12288 + 5 * 2048; E.xin0 = nullptr; E.xin1 = nullptr;
          run_gemm(lds, (const bf16_t*)(p.ws + WS_ABF), (const bf16_t*)(p.ws + WS_W + W_DOWN), 2048, FH, E); }
        GSYNC();
    }
}

extern "C" void kernel_launch(void* const* d_in, const int* in_sizes, int n_in, void* d_out, int out_size, void* d_ws, size_t ws_size, hipStream_t stream) {
    static int grid_blocks = 0;
    if (grid_blocks == 0) {
        if (n_in != 37 || ws_size < WS_END) { fprintf(stderr, "kernel_launch: unexpected n_in %d / ws %zu (need %zu)\n", n_in, ws_size, (size_t)WS_END); grid_blocks = -1; return; }
        int dev = 0, cus = 0, per_cu = 0;
        hipGetDevice(&dev);
        hipDeviceGetAttribute(&cus, hipDeviceAttributeMultiprocessorCount, dev);
        hipFuncSetAttribute((const void*)fwd_megakernel, hipFuncAttributeMaxDynamicSharedMemorySize, LDS_BYTES);
        hipOccupancyMaxActiveBlocksPerMultiprocessor(&per_cu, (const void*)fwd_megakernel, 512, LDS_BYTES);
        if (per_cu < 1) { fprintf(stderr, "kernel_launch: occupancy query says %d blocks per CU\n", per_cu); grid_blocks = -1; return; }
        grid_blocks = cus;
    }
    if (grid_blocks < 0) return;
    Params p{};
    for (int i = 0; i < 37; ++i) p.in[i] = (const float*)d_in[i];
    p.out = (float*)d_out; p.ws = (unsigned char*)d_ws;
    void* args[] = {&p};
    hipError_t e = hipLaunchCooperativeKernel((void*)fwd_megakernel, dim3(grid_blocks), dim3(512), args, LDS_BYTES, stream);
    if (e != hipSuccess) fprintf(stderr, "cooperative launch failed: %s (grid %d)\n", hipGetErrorString(e), grid_blocks);
}
```
